# Optimizing an MI355X kernel written in HIP

```python
import jax, jax.numpy as jnp
from jax import lax
import numpy as np

D_MODEL = 2048
BATCH = 2
SEQ = 8192
DEPTH = 4

N_Q_HEADS = 16
N_KV_HEADS = 4
HEAD_DIM = 64
Q_PER_KV = N_Q_HEADS // N_KV_HEADS
ATTN_WIDTH = N_Q_HEADS * HEAD_DIM
KV_WIDTH = N_KV_HEADS * HEAD_DIM
WINDOW = 128
ROPE_THETA = 500000.0
ROPE_DIM = HEAD_DIM // 4
SGU_WIDTH = D_MODEL // 2
SGU_GROUPS = 8
SGU_GROUP_DIM = SGU_WIDTH // SGU_GROUPS
CHUNK = 128
D_FF = -(-8 * D_MODEL // (3 * 256)) * 256
OFF_Q = 0
OFF_K = OFF_Q + ATTN_WIDTH
OFF_V = OFF_K + KV_WIDTH
OFF_Z = OFF_V + KV_WIDTH
OFF_G = OFF_Z + 2 * SGU_WIDTH
IN_WIDTH = OFF_G + 2 * D_MODEL
EPS = 1e-5
NEG = -1e30

kernel_name = "hybrid_swa_sink_gmlp_gated_block"


def rmsnorm(x, g):
    xf = x.astype(jnp.float32)
    y = xf * lax.rsqrt(jnp.mean(xf * xf, axis=-1, keepdims=True) + EPS) * g.astype(jnp.float32)
    return y.astype(x.dtype)


def partial_rope(t, cos, sin):
    half = ROPE_DIM // 2
    t1 = t[..., :half].astype(jnp.float32)
    t2 = t[..., half:ROPE_DIM].astype(jnp.float32)
    rot = jnp.concatenate([t1 * cos - t2 * sin, t2 * cos + t1 * sin], axis=-1).astype(t.dtype)
    return jnp.concatenate([rot, t[..., ROPE_DIM:]], axis=-1)


def sliding_window_attention(q, k, v, sinks):
    B, S = q.shape[0], q.shape[1]
    nb = S // WINDOW
    qb = q.reshape(B, nb, WINDOW, N_KV_HEADS, Q_PER_KV, HEAD_DIM)

    def band(t):
        tb = t.reshape(B, nb, WINDOW, N_KV_HEADS, HEAD_DIM)
        prev = jnp.pad(tb, ((0, 0), (1, 0), (0, 0), (0, 0), (0, 0)))[:, :-1]
        return jnp.concatenate([prev, tb], axis=2)

    kb, vb = band(k), band(v)
    scores = jnp.einsum('bnqhgd,bnkhd->bnhgqk', qb, kb).astype(jnp.float32) * (HEAD_DIM ** -0.5)
    qi = jnp.arange(WINDOW)[:, None]
    kj = jnp.arange(2 * WINDOW)[None, :]
    rel = qi + WINDOW - kj
    band_ok = (rel >= 0) & (rel < WINDOW)
    blk_ok = (jnp.arange(nb)[:, None, None] > 0) | (kj >= WINDOW)[None]
    mask = band_ok[None] & blk_ok
    scores = jnp.where(mask[None, :, None, None], scores, NEG)
    sink = sinks.astype(jnp.float32).reshape(N_KV_HEADS, Q_PER_KV)[None, None, :, :, None, None]
    sink = jnp.broadcast_to(sink, scores.shape[:-1] + (1,))
    probs = jax.nn.softmax(jnp.concatenate([scores, sink], axis=-1), axis=-1)[..., :-1]
    out = jnp.einsum('bnhgqk,bnkhd->bnqhgd', probs.astype(v.dtype), vb)
    return out.reshape(B, S, ATTN_WIDTH)


def spatial_gating(z, ln_g, ln_b, w_s, b_s):
    B, S = z.shape[0], z.shape[1]
    u, v = jnp.split(z, 2, axis=-1)
    vf = v.astype(jnp.float32)
    mu = jnp.mean(vf, axis=-1, keepdims=True)
    var = jnp.mean(jnp.square(vf - mu), axis=-1, keepdims=True)
    vn = ((vf - mu) * lax.rsqrt(var + EPS) * ln_g.astype(jnp.float32) + ln_b.astype(jnp.float32)).astype(z.dtype)
    vc = vn.reshape(B, S // CHUNK, CHUNK, SGU_GROUPS, SGU_GROUP_DIM)
    causal = jnp.tril(jnp.ones((CHUNK, CHUNK), dtype=bool))
    w = jnp.where(causal[None], w_s, jnp.zeros_like(w_s))
    sv = jnp.einsum('gts,bnsgc->bntgc', w, vc) + b_s.T[None, None, :, :, None]
    return u * sv.reshape(B, S, SGU_WIDTH)


def setup_inputs(seed: int = 0) -> dict:
    key = jax.random.key(seed)
    ks = jax.random.split(key, 20)
    f32 = jnp.float32
    nrm = lambda k, shape, scale: jax.random.normal(k, shape, f32) * scale
    x = jax.random.normal(ks[0], (BATCH, SEQ, D_MODEL), f32)
    offset = jax.random.randint(ks[1], (BATCH, 1), 0, 4096, dtype=jnp.int32)
    positions = (jnp.arange(SEQ, dtype=jnp.int32)[None, :] + offset).astype(jnp.int32)
    return {
        "x": x,
        "positions": positions,
        "norm1_g": 1.0 + nrm(ks[2], (DEPTH, D_MODEL), 0.02),
        "w_in": nrm(ks[3], (DEPTH, D_MODEL, IN_WIDTH), D_MODEL ** -0.5),
        "b_in": nrm(ks[4], (DEPTH, IN_WIDTH), 0.02),
        "sinks": nrm(ks[5], (DEPTH, N_Q_HEADS), 1.0),
        "sgu_ln_g": 1.0 + nrm(ks[6], (DEPTH, SGU_WIDTH), 0.02),
        "sgu_ln_b": nrm(ks[7], (DEPTH, SGU_WIDTH), 0.02),
        "sgu_w": nrm(ks[8], (DEPTH, SGU_GROUPS, CHUNK, CHUNK), CHUNK ** -0.5),
        "sgu_b": 1.0 + nrm(ks[9], (DEPTH, SGU_GROUPS, CHUNK), 0.02),
        "w_attn_branch": nrm(ks[10], (DEPTH, ATTN_WIDTH, D_MODEL), ATTN_WIDTH ** -0.5),
        "w_sgu_branch": nrm(ks[11], (DEPTH, SGU_WIDTH, D_MODEL), SGU_WIDTH ** -0.5),
        "w_out": nrm(ks[12], (DEPTH, D_MODEL, D_MODEL), D_MODEL ** -0.5),
        "norm2_g": 1.0 + nrm(ks[13], (DEPTH, D_MODEL), 0.02),
        "w_gate_up": nrm(ks[14], (DEPTH, D_MODEL, 2 * D_FF), D_MODEL ** -0.5),
        "w_down": nrm(ks[15], (DEPTH, D_FF, D_MODEL), D_FF ** -0.5),
        "final_g": 1.0 + nrm(ks[16], (D_MODEL,), 0.02),
    }


def reference(x, positions, norm1_g, w_in, b_in, sinks, sgu_ln_g, sgu_ln_b, sgu_w, sgu_b,
              w_attn_branch, w_sgu_branch, w_out, norm2_g, w_gate_up, w_down, final_g):
    B, S = x.shape[0], x.shape[1]
    inv_freq = ROPE_THETA ** (-jnp.arange(0, ROPE_DIM, 2, dtype=jnp.float32) / ROPE_DIM)
    ang = positions.astype(jnp.float32)[..., None] * inv_freq
    cos = jnp.cos(ang)[:, :, None, :]
    sin = jnp.sin(ang)[:, :, None, :]
    h = x
    for l in range(DEPTH):
        xn = rmsnorm(h, norm1_g[l])
        proj = jnp.einsum('bsd,de->bse', xn, w_in[l]) + b_in[l]
        q = proj[..., OFF_Q:OFF_K].reshape(B, S, N_Q_HEADS, HEAD_DIM)
        k = proj[..., OFF_K:OFF_V].reshape(B, S, N_KV_HEADS, HEAD_DIM)
        v = proj[..., OFF_V:OFF_Z].reshape(B, S, N_KV_HEADS, HEAD_DIM)
        z = jax.nn.gelu(proj[..., OFF_Z:OFF_G], approximate=False)
        gates = jax.nn.sigmoid(proj[..., OFF_G:].astype(jnp.float32)).astype(h.dtype)
        g_attn, g_sgu = jnp.split(gates, 2, axis=-1)
        q = partial_rope(q, cos, sin)
        k = partial_rope(k, cos, sin)
        y_attn = sliding_window_attention(q, k, v, sinks[l])
        y_sgu = spatial_gating(z, sgu_ln_g[l], sgu_ln_b[l], sgu_w[l], sgu_b[l])
        merged = (g_attn * jnp.einsum('bse,ed->bsd', y_attn, w_attn_branch[l])
                  + g_sgu * jnp.einsum('bse,ed->bsd', y_sgu, w_sgu_branch[l]))
        h = h + jnp.einsum('bsd,de->bse', merged, w_out[l])
        hn = rmsnorm(h, norm2_g[l])
        gu = jnp.einsum('bsd,df->bsf', hn, w_gate_up[l])
        gate, up = jnp.split(gu, 2, axis=-1)
        h = h + jnp.einsum('bsf,fd->bsd', jax.nn.silu(gate) * up, w_down[l])
    return rmsnorm(h, final_g)
```

```cpp
#include <hip/hip_runtime.h>
#include <cstdio>
#include <cstdint>
namespace pg8 {
#define PG8_LAS __attribute__((address_space(3)))
typedef unsigned short bf16_t;
typedef short bf16x8 __attribute__((ext_vector_type(8)));
typedef float f32x4 __attribute__((ext_vector_type(4)));
typedef unsigned u32x4 __attribute__((ext_vector_type(4)));
constexpr int BM = 256, BK = 64, HALF = 128, HTB = HALF * BK * 2  , STAGE_BYTES = 8 * HTB, NXCD = 8, WGM = 8;

__host__ __device__ __forceinline__ int lds_byte(int r, int c) { const int st = (r >> 4) * 2 + (c >> 5), rr = r & 15, cc = c & 31, ob = rr * 64 + cc * 2; return st * 1024 + (ob ^ (((ob >> 9) & 1) << 5)); }
__host__ __device__ __forceinline__ void stage_rc(int b, int& R, int& C) { const int st = b / 1024, sb = b % 1024, swz = sb ^ (((sb >> 9) & 1) << 5); R = (st >> 1) * 16 + swz / 64; C = (st & 1) * 32 + (swz % 64) / 2; }
__host__ __device__ __forceinline__ int perm32(int rho) { const int n = rho >> 4, i = rho & 15; return 8 * (i >> 2) + 4 * n + (i & 3); }

struct Unit { int pm, pn; };
struct Gemm { const bf16_t* A; const bf16_t* Bt; int M, N, K; };

struct StaticOrder {
    int nM, nN, nwg, G, c;
    __host__ __device__ void init(int M, int N, int G_, int c_) { nM = M / BM; nN = N / BM; nwg = nM * nN; G = G_; c = c_; }
    __host__ __device__ bool next(int i, Unit& u) const {
        const long L = (long)i * G + c; if (L >= nwg) return false;
        int wgid = (int)L; { const int q = nwg / NXCD, r = nwg % NXCD, xcd = wgid % NXCD, off = wgid / NXCD; wgid = (xcd < r ? xcd * (q + 1) : r * (q + 1) + (xcd - r) * q) + off; }
        const int nig = WGM * nN, gid = wgid / nig, fm = gid * WGM, gsz = (nM - fm) < WGM ? (nM - fm) : WGM;
        u.pm = fm + ((wgid % nig) % gsz); u.pn = (wgid % nig) / gsz; return true;
    }
    __device__ __forceinline__ void a_ready(const Unit&) const {}
    __device__ __forceinline__ void done(const Unit&) const {}
};

__device__ __forceinline__ unsigned cvt_pk_bf16(float lo, float hi) { unsigned r; asm volatile("v_cvt_pk_bf16_f32 %0, %1, %2" : "=v"(r) : "v"(lo), "v"(hi)); return r; }
typedef float f32x2 __attribute__((ext_vector_type(2)));
__device__ __forceinline__ f32x2 gelu_pk(f32x2 v) {
    const f32x2 av = __builtin_elementwise_abs(v), d = av * 0.2316418882f + 1.0f;
    f32x2 t; t.x = __builtin_amdgcn_rcpf(d.x); t.y = __builtin_amdgcn_rcpf(d.y);
    f32x2 q = t * 0.5307027145f + (-0.7265760135f); q = q * t + 0.7107068705f; q = q * t + (-0.142248368f); q = q * t + 0.127414796f; q = q * t;
    const f32x2 s = (v * v) * (-0.72134752044f);
    f32x2 e; e.x = __builtin_amdgcn_exp2f(s.x); e.y = __builtin_amdgcn_exp2f(s.y);
    const f32x2 m = v * (q * e), r = v - m;
    f32x2 o; o.x = v.x < 0.f ? m.x : r.x; o.y = v.y < 0.f ? m.y : r.y; return o;
}

template <int ACT  > struct EpiBf16 {
    static constexpr bool PERM = true, AFTER_DRAIN = false; static_assert(ACT == 0 || ACT == 1, "EpiBf16: ACT is 0 (none) or 1 (gelu_pk)");
    bf16_t* O; int ldc; const float* bias; int split_cols; size_t split_stride; float scale0;
    __device__ __forceinline__ void operator()(const f32x4 (&acc)[2][2][4][2], const Unit& u, int wr, int wc, int fr, int fq) const {
        const int row0 = u.pm * BM + wr * 64 + fr; int colt = u.pn * BM; bf16_t* base = O;
        float sc = 1.f; if (split_cols) { const int t = colt / split_cols; base += (size_t)t * split_stride; colt -= t * split_cols; if (t == 0) sc = scale0; }
        const int col0 = colt + wc * 32 + 8 * fq, bcol0 = u.pn * BM + wc * 32 + 8 * fq;
        f32x4 bv[2][2];
#pragma unroll
        for (int bj = 0; bj < 2; ++bj)
#pragma unroll
            for (int n = 0; n < 2; ++n) bv[bj][n] = bias ? *(const f32x4*)(bias + bcol0 + bj * HALF + 4 * n) : (f32x4){0.f, 0.f, 0.f, 0.f};
#pragma unroll
        for (int ai = 0; ai < 2; ++ai)
#pragma unroll
            for (int m = 0; m < 4; ++m) { bf16_t* rowp = base + (size_t)(row0 + ai * HALF + m * 16) * ldc + col0;
#pragma unroll
                for (int bj = 0; bj < 2; ++bj) { f32x4 v0 = acc[ai][bj][m][0] + bv[bj][0], v1 = acc[ai][bj][m][1] + bv[bj][1];
                    if (ACT == 1) { f32x2 a = gelu_pk((f32x2){v0[0], v0[1]}), b = gelu_pk((f32x2){v0[2], v0[3]}), c = gelu_pk((f32x2){v1[0], v1[1]}), d = gelu_pk((f32x2){v1[2], v1[3]});
                        v0 = (f32x4){a.x, a.y, b.x, b.y}; v1 = (f32x4){c.x, c.y, d.x, d.y}; }
                    v0 = v0 * sc; v1 = v1 * sc; u32x4 w; w.x = cvt_pk_bf16(v0[0], v0[1]); w.y = cvt_pk_bf16(v0[2], v0[3]); w.z = cvt_pk_bf16(v1[0], v1[1]); w.w = cvt_pk_bf16(v1[2], v1[3]);
                    *(u32x4*)(rowp + bj * HALF) = w; } }
    }
};


template <class Epi, class Sched, bool ALIGN_EPI = false, bool SP2 = false>
__device__ __forceinline__ void gemm_phase(PG8_LAS unsigned char* lds, const Gemm g, const Sched& S, const Epi& E) {
    int tid_ = threadIdx.x; asm volatile("" : "+v"(tid_));
    const int tid = tid_, wid = __builtin_amdgcn_readfirstlane(tid >> 6), lane = tid & 63, wr = wid >> 2, wc = wid & 3, fr = lane & 15, fq = lane >> 4;
    const int K = g.K, nt = K / BK;
    unsigned voffA[2], voffB[2];
#pragma unroll
    for (int i = 0; i < 2; ++i) { int R, C; stage_rc(tid * 16 + i * 8192, R, C); const int Rb = Epi::PERM ? ((R & ~31) + perm32(R & 31)) : R;
        voffA[i] = (unsigned)(R * K + C) * 2u; voffB[i] = (unsigned)(Rb * K + C) * 2u; }
    const size_t kstep = (size_t)(BK * 2);
    const size_t hstep = (size_t)HALF * K * 2;
    const size_t tstep = 2 * hstep;
    const unsigned ldsw = (unsigned)wid * 1024u;
    const int aoff = lds_byte(wr * 64 + fr, fq * 8), boff = lds_byte(wc * 32 + fr, fq * 8);
#define PG8_SA(b, h) (((b) * 2 + (h)) * HTB)
#define PG8_SB(b, h) ((4 + (b) * 2 + (h)) * HTB)
#define PG8_STAGE(bufoff, gbase, voff) do { _Pragma("unroll") for (int _i = 0; _i < 2; ++_i) \
        __builtin_amdgcn_global_load_lds((const unsigned*)((const char*)(gbase) + (voff)[_i]), (PG8_LAS unsigned*)(lds + (bufoff) + ldsw + _i * 8192), 16, 0, 0); } while (0)
#define PG8_LDA(dst, b, h) do { _Pragma("unroll") for (int m = 0; m < 4; ++m) _Pragma("unroll") for (int k = 0; k < 2; ++k) dst[m][k] = *(const PG8_LAS bf16x8*)(lds + PG8_SA(b, h) + aoff + m * 2048 + k * 1024); } while (0)
#define PG8_LDB(dst, b, h) do { _Pragma("unroll") for (int n = 0; n < 2; ++n) _Pragma("unroll") for (int k = 0; k < 2; ++k) dst[n][k] = *(const PG8_LAS bf16x8*)(lds + PG8_SB(b, h) + boff + n * 2048 + k * 1024); } while (0)
#define PG8_MMA(ai, bj, At, Bt) do { __builtin_amdgcn_s_setprio(1); _Pragma("unroll") for (int m = 0; m < 4; ++m) _Pragma("unroll") for (int n = 0; n < 2; ++n) _Pragma("unroll") for (int k = 0; k < 2; ++k) \
        acc[ai][bj][m][n] = __builtin_amdgcn_mfma_f32_16x16x32_bf16(Bt[n][k], At[m][k], acc[ai][bj][m][n], 0, 0, 0); __builtin_amdgcn_s_setprio(0); } while (0)
#define PG8_WAIT_V(n) asm volatile("s_waitcnt vmcnt(" #n ")" ::: "memory")
#define PG8_WAIT_L(n) asm volatile("s_waitcnt lgkmcnt(" #n ")" ::: "memory")
#define PG8_BAR __builtin_amdgcn_s_barrier()
#define PG8_SCHED __builtin_amdgcn_sched_barrier(0)
    Unit cur, nxt; int ui = 0;
    if (!S.next(0, cur)) return;
    f32x4 acc[2][2][4][2];
#pragma unroll
    for (int a = 0; a < 2; ++a)
#pragma unroll
        for (int b = 0; b < 2; ++b)
#pragma unroll
            for (int m = 0; m < 4; ++m)
#pragma unroll
                for (int n = 0; n < 2; ++n) acc[a][b][m][n] = (f32x4){0.f, 0.f, 0.f, 0.f};
    bf16x8 At[4][2], B0[2][2], B1[2][2];
    const char* cA = (const char*)g.A + (size_t)cur.pm * tstep; const char* cB = (const char*)g.Bt + (size_t)cur.pn * tstep;
    S.a_ready(cur);
    if constexpr (SP2) {
        PG8_STAGE(PG8_SB(0, 0), cB, voffB); PG8_STAGE(PG8_SB(0, 1), cB + hstep, voffB); PG8_STAGE(PG8_SA(0, 0), cA, voffA); PG8_STAGE(PG8_SA(0, 1), cA + hstep, voffA);
        if (wr == 1) PG8_BAR;
        PG8_WAIT_V(2); PG8_BAR;
        PG8_STAGE(PG8_SB(1, 0), cB + kstep, voffB); PG8_STAGE(PG8_SA(1, 0), cA + kstep, voffA); PG8_STAGE(PG8_SB(1, 1), cB + hstep + kstep, voffB);
        PG8_WAIT_V(6); PG8_BAR;
    } else {
        PG8_STAGE(PG8_SB(0, 0), cB, voffB); PG8_STAGE(PG8_SA(0, 0), cA, voffA); PG8_STAGE(PG8_SB(0, 1), cB + hstep, voffB); PG8_STAGE(PG8_SA(0, 1), cA + hstep, voffA);
        if (wr == 1) PG8_BAR;
        PG8_WAIT_V(4); PG8_BAR;
        PG8_STAGE(PG8_SB(1, 0), cB + kstep, voffB); PG8_STAGE(PG8_SA(1, 0), cA + kstep, voffA); PG8_STAGE(PG8_SB(1, 1), cB + hstep + kstep, voffB);
        PG8_WAIT_V(6); PG8_BAR;
    }
    for (;;) {
        const bool has_next = S.next(ui + 1, nxt);
        const char* nA = has_next ? (const char*)g.A + (size_t)nxt.pm * tstep : cA; const char* nB = has_next ? (const char*)g.Bt + (size_t)nxt.pn * tstep : cB;
        for (int t = 0; t < nt; t += 2) {
            const bool last = (t == nt - 2);
            const char* a1 = cA + (size_t)(t + 1) * kstep;
            const char* a2 = last ? nA : cA + (size_t)(t + 2) * kstep; const char* b2 = last ? nB : cB + (size_t)(t + 2) * kstep;
            const char* a3 = a2 + kstep; const char* b3 = b2 + kstep;
            if (last && has_next) S.a_ready(nxt);
            if constexpr (SP2) {
            PG8_LDB(B0, 0, 0); PG8_LDB(B1, 0, 1); PG8_SCHED; PG8_LDA(At, 0, 0); PG8_STAGE(PG8_SA(1, 1), a1 + hstep, voffA);
            PG8_WAIT_V(8); PG8_WAIT_L(0); PG8_BAR; PG8_MMA(0, 0, At, B0); PG8_MMA(0, 1, At, B1); PG8_BAR; PG8_SCHED;
            PG8_LDA(At, 0, 1); PG8_STAGE(PG8_SB(0, 0), b2, voffB); PG8_STAGE(PG8_SB(0, 1), b2 + hstep, voffB); PG8_STAGE(PG8_SA(0, 0), a2, voffA);
            PG8_WAIT_V(8); PG8_WAIT_L(0); PG8_BAR; PG8_MMA(1, 0, At, B0); PG8_MMA(1, 1, At, B1); PG8_BAR; PG8_SCHED;
            PG8_LDB(B0, 1, 0); PG8_LDB(B1, 1, 1); PG8_SCHED; PG8_LDA(At, 1, 0); PG8_STAGE(PG8_SA(0, 1), a2 + hstep, voffA);
            PG8_WAIT_V(8); PG8_WAIT_L(0); PG8_BAR; PG8_MMA(0, 0, At, B0); PG8_MMA(0, 1, At, B1); PG8_BAR; PG8_SCHED;
            PG8_LDA(At, 1, 1); PG8_STAGE(PG8_SB(1, 0), b3, voffB); PG8_STAGE(PG8_SB(1, 1), b3 + hstep, voffB); PG8_STAGE(PG8_SA(1, 0), a3, voffA);
            PG8_WAIT_V(8); PG8_WAIT_L(0); PG8_BAR; PG8_MMA(1, 0, At, B0); PG8_MMA(1, 1, At, B1); PG8_BAR; PG8_SCHED;
            } else {
            PG8_LDB(B0, 0, 0); PG8_SCHED; PG8_LDA(At, 0, 0); PG8_STAGE(PG8_SA(1, 1), a1 + hstep, voffA);
            PG8_WAIT_L(8); PG8_BAR; PG8_WAIT_L(0); PG8_MMA(0, 0, At, B0); PG8_BAR; PG8_SCHED;
            PG8_LDB(B1, 0, 1); PG8_STAGE(PG8_SB(0, 0), b2, voffB);
            PG8_BAR; PG8_WAIT_L(0); PG8_MMA(0, 1, At, B1); PG8_BAR;
            PG8_LDA(At, 0, 1); PG8_STAGE(PG8_SA(0, 0), a2, voffA);
            PG8_BAR; PG8_WAIT_L(0); PG8_MMA(1, 0, At, B0); PG8_BAR; PG8_SCHED;
            PG8_STAGE(PG8_SB(0, 1), b2 + hstep, voffB);
            PG8_WAIT_V(6); PG8_BAR; PG8_MMA(1, 1, At, B1); PG8_BAR;
            PG8_LDB(B0, 1, 0); PG8_SCHED; PG8_LDA(At, 1, 0); PG8_STAGE(PG8_SA(0, 1), a2 + hstep, voffA);
            PG8_WAIT_L(8); PG8_BAR; PG8_WAIT_L(0); PG8_MMA(0, 0, At, B0); PG8_BAR; PG8_SCHED;
            PG8_LDB(B1, 1, 1); PG8_STAGE(PG8_SB(1, 0), b3, voffB);
            PG8_BAR; PG8_WAIT_L(0); PG8_MMA(0, 1, At, B1); PG8_BAR;
            PG8_LDA(At, 1, 1); PG8_STAGE(PG8_SA(1, 0), a3, voffA);
            PG8_BAR; PG8_WAIT_L(0); PG8_MMA(1, 0, At, B0); PG8_BAR; PG8_SCHED;
            PG8_STAGE(PG8_SB(1, 1), b3 + hstep, voffB);
            PG8_WAIT_V(6); PG8_BAR; PG8_MMA(1, 1, At, B1); PG8_BAR;
            }
        }
        if constexpr (ALIGN_EPI) { if (wr == 0) PG8_BAR; }
        if constexpr (!Epi::AFTER_DRAIN) { E(acc, cur, wr, wc, fr, fq); S.done(cur); }
        if (!has_next) break;
#pragma unroll
        for (int a = 0; a < 2; ++a)
#pragma unroll
            for (int b = 0; b < 2; ++b)
#pragma unroll
                for (int m = 0; m < 4; ++m)
#pragma unroll
                    for (int n = 0; n < 2; ++n) acc[a][b][m][n] = (f32x4){0.f, 0.f, 0.f, 0.f};
        cur = nxt; cA = nA; cB = nB; ++ui;
        if constexpr (ALIGN_EPI) { if (wr == 1) PG8_BAR; }
    }
    PG8_WAIT_V(0);
    if constexpr (!ALIGN_EPI) { if (wr == 0) PG8_BAR; }
    PG8_BAR;
    if constexpr (Epi::AFTER_DRAIN) { E.fused(acc, cur, wr, wc, fr, fq, lds, wid, lane); S.done(cur); }
#undef PG8_SA
#undef PG8_SB
#undef PG8_STAGE
#undef PG8_LDA
#undef PG8_LDB
#undef PG8_MMA
#undef PG8_WAIT_V
#undef PG8_WAIT_L
#undef PG8_BAR
#undef PG8_SCHED
}
}

#define GAS __attribute__((address_space(1)))
#define LAS __attribute__((address_space(3)))
typedef unsigned short bf16;
typedef unsigned v4u __attribute__((ext_vector_type(4)));
typedef float f32x4 __attribute__((ext_vector_type(4)));
typedef short bf16x8 __attribute__((ext_vector_type(8)));
typedef GAS unsigned gu32;
typedef GAS unsigned long long gu64;
#define RLX_AGENT __ATOMIC_RELAXED, __HIP_MEMORY_SCOPE_AGENT
#define LDS_WAIT() asm volatile("s_waitcnt lgkmcnt(0)" ::: "memory")
#define VM_WAIT() asm volatile("s_waitcnt vmcnt(0)" ::: "memory")
__device__ __forceinline__ unsigned long long rt() { return __builtin_amdgcn_s_memrealtime(); }
__device__ __forceinline__ unsigned f2bf(float f) { unsigned u = __builtin_bit_cast(unsigned, f); return (u + 0x7fffu + ((u >> 16) & 1u)) >> 16; }
__device__ __forceinline__ unsigned pk2(float lo, float hi) { return f2bf(lo) | (f2bf(hi) << 16); }

#define XB_TMO      128
#define XB_XCNT(j)  (256  + 64 * (j))
#define XB_XSUB(j)  (1280 + 64 * (j))
#define XB_XGEN(j)  (2304 + 64 * (j))
#define XB_TOP      3328
#define XB_TOPGEN   3392
#define XCD_BAR_WORDS 3456
#define XB_SPIN_CAP (1u << 18)

__device__ __forceinline__ unsigned xb_ld(unsigned* p)              { return __hip_atomic_load(p, __ATOMIC_RELAXED, __HIP_MEMORY_SCOPE_AGENT); }
__device__ __forceinline__ unsigned xb_add(unsigned* p, unsigned v) { return __hip_atomic_fetch_add(p, v, __ATOMIC_RELAXED, __HIP_MEMORY_SCOPE_AGENT); }
__device__ __forceinline__ unsigned xb_xcc_id() { return (unsigned)__builtin_amdgcn_s_getreg((3 << 11) | 20) & 0xFu; }
#define XB_SPIN(cond, bar) do { unsigned _sp = 0; while (cond) { __builtin_amdgcn_s_sleep(1); \
    if ((++_sp & 255u) == 0u) { if (xb_ld(&(bar)[XB_TMO])) break; if (_sp > XB_SPIN_CAP) { atomicAdd(&(bar)[XB_TMO], 1u); break; } } } } while (0)

struct XcdBarrier {
    unsigned* bar; unsigned x;
    volatile LAS unsigned* st;
};

__device__ __forceinline__ XcdBarrier xcd_barrier_post(unsigned* bar, volatile LAS unsigned* st) {
    XcdBarrier b; b.bar = bar; b.x = xb_xcc_id(); b.st = st;
    if (threadIdx.x == 0) (void)xb_add(&bar[XB_XCNT(b.x)], 1u);
    return b;
}
__device__ __forceinline__ void xcd_barrier_complete(unsigned* bar, unsigned x, unsigned& nloc, unsigned& nx) {
    const unsigned G = gridDim.x * gridDim.y * gridDim.z;
    unsigned sum, cnt, mine, sp = 0u;
    for (;;) {
        sum = 0u; cnt = 0u; mine = 0u;
#pragma unroll
        for (unsigned j = 0; j < 16; ++j) { const unsigned c = xb_ld(&bar[XB_XCNT(j)]); sum += c; cnt += (c > 0u) ? 1u : 0u; mine = (j == x) ? c : mine; }
        if (sum == G) break;
        __builtin_amdgcn_s_sleep(1);
        if ((++sp & 255u) == 0u) { if (xb_ld(&bar[XB_TMO])) break; if (sp > XB_SPIN_CAP) { atomicAdd(&bar[XB_TMO], 1u); break; } }
    }
    nloc = mine > 0u ? mine : 1u; nx = cnt > 0u ? cnt : 1u;
}

__device__ __forceinline__ void xcd_barrier(const XcdBarrier& b) {
    asm volatile("s_waitcnt vmcnt(0)" ::: "memory");
    __syncthreads();
    if (threadIdx.x == 0) {
        unsigned* bar = b.bar;
        __builtin_amdgcn_s_waitcnt(0);
        unsigned nloc = b.st[0], nx = b.st[1];
        if (nloc == 0u) { xcd_barrier_complete(bar, b.x, nloc, nx); b.st[0] = nloc; b.st[1] = nx; }
        const unsigned old = xb_add(&bar[XB_XSUB(b.x)], 1u);
        const unsigned gen = old / nloc;
        if (old + 1u == (gen + 1u) * nloc) {
            __builtin_amdgcn_fence(__ATOMIC_RELEASE, "agent");
            asm volatile("s_waitcnt vmcnt(0)" ::: "memory");
            const unsigned og = xb_add(&bar[XB_TOP], 1u);
            const unsigned tg = og / nx;
            if (og + 1u == (tg + 1u) * nx) xb_add(&bar[XB_TOPGEN], 1u);
            else XB_SPIN(xb_ld(&bar[XB_TOPGEN]) == tg, bar);
            __builtin_amdgcn_fence(__ATOMIC_ACQUIRE, "agent");
            xb_add(&bar[XB_XGEN(b.x)], 1u);
            asm volatile("s_waitcnt vmcnt(0)" ::: "memory");
        } else {
            XB_SPIN(xb_ld(&bar[XB_XGEN(b.x)]) == gen, bar);
            __builtin_amdgcn_fence(__ATOMIC_ACQUIRE, "agent");
            asm volatile("s_waitcnt vmcnt(0)" ::: "memory");
        }
    }
    __syncthreads();
}


constexpr int NWAVES = 8;
#ifndef MK_ONE_LAUNCH
#define MK_ONE_LAUNCH 1
#endif
constexpr int BATCH = 2, SEQ = 8192, M = BATCH * SEQ, DM = 2048, DEPTH = 4;
constexpr int NQH = 16, NKVH = 4, HD = 64, AW = 1024, KVW = 256, WIN = 128;
constexpr int SGUW = 1024, SGUG = 8, CHUNK = 128, DFF = 5632;
constexpr int OFF_Q = 0, OFF_K = 1024, OFF_V = 1280, OFF_Z = 1536, OFF_G = 3584, INW = 7680;
constexpr float EPS = 1e-5f;

constexpr size_t MiB = 1u << 20;
constexpr size_t WS_CTL = 0, CTL_ZERO_BYTES = 1 * MiB;
constexpr size_t WS_CS = 1 * MiB;
constexpr size_t WS_RSTD1 = 2 * MiB, WS_RSTD2 = WS_RSTD1 + 64 * 1024, WS_MU = WS_RSTD2 + 64 * 1024, WS_RSTDV = WS_MU + 64 * 1024;
constexpr size_t WS_W = 4 * MiB, W_LAYER = 112 * MiB;
constexpr size_t WL_IN = 0, WL_AB = 30 * MiB, WL_SB = 34 * MiB, WL_OUT = 38 * MiB, WL_GU = 46 * MiB, WL_DN = 90 * MiB;
constexpr size_t WS_HB = WS_W + DEPTH * W_LAYER;
constexpr size_t WS_Q = WS_HB + 64 * MiB, WS_K = WS_Q + 32 * MiB, WS_V = WS_K + 8 * MiB;
constexpr size_t WS_Z = WS_V + 8 * MiB;
constexpr size_t WS_G = WS_Z + 64 * MiB;
constexpr size_t WS_Y = WS_G + 128 * MiB;
constexpr size_t WS_MG = WS_Y + 64 * MiB;
constexpr size_t WS_ACT = WS_MG + 64 * MiB;
constexpr size_t WS_T = WS_ACT;
constexpr size_t WS_END = WS_ACT + 176 * MiB;
static_assert((size_t)INW * DM * 2 <= 30 * MiB && (size_t)2 * DM * DFF * 2 <= 44 * MiB && (size_t)DM * DFF * 2 <= 22 * MiB, "weight map");
static_assert((size_t)M * DFF * 2 <= 176 * MiB && (size_t)M * DM * 4 <= 176 * MiB, "act map");
constexpr int CW_BAR = 4096;

constexpr int RING_BYTES = 131072, LDSCTL_OFF = RING_BYTES, MISC_OFF = LDSCTL_OFF + 320, LDS_BYTES = 147456;

typedef unsigned v2u __attribute__((ext_vector_type(2)));
typedef float f32x2 __attribute__((ext_vector_type(2)));
__device__ __forceinline__ float bf2f(unsigned h) { return __builtin_bit_cast(float, h << 16); }
__device__ __forceinline__ float bflo(unsigned w) { return __builtin_bit_cast(float, w << 16); }
__device__ __forceinline__ float bfhi(unsigned w) { return __builtin_bit_cast(float, w & 0xffff0000u); }
__device__ __forceinline__ float wave_sum(float v) {
#pragma unroll
    for (int o = 1; o < 64; o <<= 1) v += __shfl_xor(v, o);
    return v;
}
__device__ __forceinline__ float wave_max(float v) {
#pragma unroll
    for (int o = 1; o < 64; o <<= 1) v = fmaxf(v, __shfl_xor(v, o));
    return v;
}
__device__ __forceinline__ float sigmoidf_(float x) { return __builtin_amdgcn_rcpf(1.0f + __builtin_amdgcn_exp2f(-1.4426950408889634f * x)); }

namespace pg8 {
struct EpiInProj {
    static constexpr bool PERM = true, AFTER_DRAIN = false;
    const float* rstd; const float* bias; bf16_t *q, *k, *v, *z, *g;
    __device__ __forceinline__ void operator()(const f32x4 (&acc)[2][2][4][2], const Unit& u, int wr, int wc, int fr, int fq) const {
        const int row0 = u.pm * BM + wr * 64 + fr; const int colt = u.pn * BM;
        bf16_t* base; int ldc, cb, mode;
        if (colt < OFF_K) { base = q; ldc = AW; cb = colt; mode = 0; }
        else if (colt < OFF_V) { base = k; ldc = KVW; cb = colt - OFF_K; mode = 0; }
        else if (colt < OFF_Z) { base = v; ldc = KVW; cb = colt - OFF_V; mode = 0; }
        else if (colt < OFF_G) { base = z; ldc = 2 * SGUW; cb = colt - OFF_Z; mode = 1; }
        else { base = g; ldc = 2 * DM; cb = colt - OFF_G; mode = 2; }
        const int col0 = cb + wc * 32 + 8 * fq, bcol0 = colt + wc * 32 + 8 * fq;
        f32x4 bv[2][2];
#pragma unroll
        for (int bj = 0; bj < 2; ++bj)
#pragma unroll
            for (int n = 0; n < 2; ++n) bv[bj][n] = *(const f32x4*)(bias + bcol0 + bj * HALF + 4 * n);
#pragma unroll
        for (int ai = 0; ai < 2; ++ai)
#pragma unroll
            for (int m = 0; m < 4; ++m) { const int r = row0 + ai * HALF + m * 16; const float rs = rstd[r]; bf16_t* rowp = base + (size_t)r * ldc + col0;
#pragma unroll
                for (int bj = 0; bj < 2; ++bj) { f32x4 v0 = acc[ai][bj][m][0] * rs + bv[bj][0], v1 = acc[ai][bj][m][1] * rs + bv[bj][1];
                    if (mode == 1) { f32x2 a = gelu_pk((f32x2){v0[0], v0[1]}), b = gelu_pk((f32x2){v0[2], v0[3]}), c = gelu_pk((f32x2){v1[0], v1[1]}), d = gelu_pk((f32x2){v1[2], v1[3]});
                        v0 = (f32x4){a.x, a.y, b.x, b.y}; v1 = (f32x4){c.x, c.y, d.x, d.y}; }
                    if (mode == 2) {
#pragma unroll
                        for (int j = 0; j < 4; ++j) { v0[j] = sigmoidf_(v0[j]); v1[j] = sigmoidf_(v1[j]); } }
                    u32x4 w; w.x = cvt_pk_bf16(v0[0], v0[1]); w.y = cvt_pk_bf16(v0[2], v0[3]); w.z = cvt_pk_bf16(v1[0], v1[1]); w.w = cvt_pk_bf16(v1[2], v1[3]);
                    *(u32x4*)(rowp + bj * HALF) = w; } }
    }
};
struct EpiGate {
    static constexpr bool PERM = true, AFTER_DRAIN = false;
    const bf16_t* gates; float* T; bf16_t* mg;
    __device__ __forceinline__ void operator()(const f32x4 (&acc)[2][2][4][2], const Unit& u, int wr, int wc, int fr, int fq) const {
        const int br = u.pn >> 3, pn = u.pn & 7, pm = u.pm & 63;
        const int row0 = pm * BM + wr * 64 + fr, col0 = pn * BM + wc * 32 + 8 * fq;
#pragma unroll
        for (int ai = 0; ai < 2; ++ai)
#pragma unroll
            for (int m = 0; m < 4; ++m) { const int r = row0 + ai * HALF + m * 16;
#pragma unroll
                for (int bj = 0; bj < 2; ++bj) { const int c = col0 + bj * HALF;
                    const u32x4 gw = *(const u32x4*)(gates + (size_t)r * (2 * DM) + br * DM + c);
                    f32x4 g0 = (f32x4){bflo(gw.x), bfhi(gw.x), bflo(gw.y), bfhi(gw.y)}, g1 = (f32x4){bflo(gw.z), bfhi(gw.z), bflo(gw.w), bfhi(gw.w)};
                    f32x4 v0 = acc[ai][bj][m][0] * g0, v1 = acc[ai][bj][m][1] * g1;
                    float* tp = T + (size_t)r * DM + c;
                    if (br == 0) { *(f32x4*)tp = v0; *(f32x4*)(tp + 4) = v1; }
                    else { v0 += *(const f32x4*)tp; v1 += *(const f32x4*)(tp + 4);
                        u32x4 w; w.x = cvt_pk_bf16(v0[0], v0[1]); w.y = cvt_pk_bf16(v0[2], v0[3]); w.z = cvt_pk_bf16(v1[0], v1[1]); w.w = cvt_pk_bf16(v1[2], v1[3]);
                        *(u32x4*)(mg + (size_t)r * DM + c) = w; } } }
    }
};
struct EpiResid {
    static constexpr bool PERM = true, AFTER_DRAIN = false;
    float* h; bf16_t* hb;
    __device__ __forceinline__ void operator()(const f32x4 (&acc)[2][2][4][2], const Unit& u, int wr, int wc, int fr, int fq) const {
        const int row0 = u.pm * BM + wr * 64 + fr, col0 = u.pn * BM + wc * 32 + 8 * fq;
#pragma unroll
        for (int ai = 0; ai < 2; ++ai)
#pragma unroll
            for (int m = 0; m < 4; ++m) { const int r = row0 + ai * HALF + m * 16;
#pragma unroll
                for (int bj = 0; bj < 2; ++bj) { const int c = col0 + bj * HALF; float* hp = h + (size_t)r * DM + c;
                    f32x4 v0 = acc[ai][bj][m][0] + *(const f32x4*)hp, v1 = acc[ai][bj][m][1] + *(const f32x4*)(hp + 4);
                    *(f32x4*)hp = v0; *(f32x4*)(hp + 4) = v1;
                    u32x4 w; w.x = cvt_pk_bf16(v0[0], v0[1]); w.y = cvt_pk_bf16(v0[2], v0[3]); w.z = cvt_pk_bf16(v1[0], v1[1]); w.w = cvt_pk_bf16(v1[2], v1[3]);
                    *(u32x4*)(hb + (size_t)r * DM + c) = w; } }
    }
};
struct EpiSwiglu {
    static constexpr bool PERM = true, AFTER_DRAIN = false;
    const float* rstd; bf16_t* act;
    __device__ __forceinline__ void operator()(const f32x4 (&acc)[2][2][4][2], const Unit& u, int wr, int wc, int fr, int fq) const {
        const int row0 = u.pm * BM + wr * 64 + fr, col0 = u.pn * HALF + wc * 32 + 8 * fq;
#pragma unroll
        for (int ai = 0; ai < 2; ++ai)
#pragma unroll
            for (int m = 0; m < 4; ++m) { const int r = row0 + ai * HALF + m * 16; const float rs = rstd[r];
                f32x4 o[2];
#pragma unroll
                for (int n = 0; n < 2; ++n) { const f32x4 gg = acc[ai][0][m][n] * rs, uu = acc[ai][1][m][n] * rs;
#pragma unroll
                    for (int j = 0; j < 4; ++j) o[n][j] = gg[j] * sigmoidf_(gg[j]) * uu[j]; }
                u32x4 w; w.x = cvt_pk_bf16(o[0][0], o[0][1]); w.y = cvt_pk_bf16(o[0][2], o[0][3]); w.z = cvt_pk_bf16(o[1][0], o[1][1]); w.w = cvt_pk_bf16(o[1][2], o[1][3]);
                *(u32x4*)(act + (size_t)r * DFF + col0) = w; }
    }
};
struct PairOrder {
    StaticOrder base;
    __device__ __forceinline__ bool next(int i, Unit& u) const { Unit t; if (!base.next(i >> 1, t)) return false; const int br = i & 1; u.pm = t.pm + (M / BM) * br; u.pn = t.pn + (DM / BM) * br; return true; }
    __device__ __forceinline__ void a_ready(const Unit&) const {}
    __device__ __forceinline__ void done(const Unit&) const {}
};
}

struct Frame {
    LAS unsigned char* lds; volatile LAS unsigned* MISC; gu32* ctl;
    int tid, lane, wave, vcu, G;
};
struct Args { const void* in[17]; float* out; unsigned char* ws; int ph_lo, ph_hi, li, pad; };
enum { I_X = 0, I_POS, I_N1G, I_WIN, I_BIN, I_SINKS, I_LNG, I_LNB, I_SGUW, I_SGUB, I_WAB, I_WSB, I_WOUT, I_N2G, I_WGU, I_WDN, I_FG };

__device__ __forceinline__ void transpose_item(const float* W, int K, int N, bf16* WT, const float* gain, int mode, LAS float* scr, int item, int lane) {
    const int nblk = N / 32, kb = item / nblk, nb = item % nblk, k0 = 64 * kb, n0 = 32 * nb;
#pragma unroll 8
    for (int i = 0; i < 32; ++i) { const int kk = 2 * i + (lane >> 5); float w = W[(size_t)(k0 + kk) * N + n0 + (lane & 31)]; if (gain) w *= gain[k0 + kk]; scr[kk * 33 + (lane & 31)] = w; }
    LDS_WAIT(); asm volatile("" ::: "memory");
    int d0 = n0;
    if (mode == 1) { const int bj = n0 / DFF, rem = n0 % DFF; d0 = 256 * (rem / 128) + 128 * bj + (rem % 128); }
    const int c = lane & 7;
#pragma unroll
    for (int j = 0; j < 4; ++j) { const int n = (lane >> 3) + 8 * j; const LAS float* s = scr + (8 * c) * 33 + n;
        v4u o; o.x = pk2(s[0 * 33], s[1 * 33]); o.y = pk2(s[2 * 33], s[3 * 33]); o.z = pk2(s[4 * 33], s[5 * 33]); o.w = pk2(s[6 * 33], s[7 * 33]);
        *(GAS v4u*)(WT + (size_t)(d0 + n) * K + k0 + 8 * c) = o; }
    LDS_WAIT(); asm volatile("" ::: "memory");
}
__device__ __forceinline__ void sincos_red(float ang, float& c, float& s) {
    const double a = (double)ang; const double kq = __builtin_rint(a * 0.63661977236758134308);
    const double r = __builtin_fma(-kq, 1.57079632679489661923, a) - kq * 6.123233995736766e-17; const double r2 = r * r;
    double sp = -2.5052108385441718775e-8; sp = sp * r2 + 2.7557319223985890653e-6; sp = sp * r2 - 1.9841269841269841253e-4; sp = sp * r2 + 8.3333333333333332177e-3; sp = sp * r2 - 1.6666666666666665741e-1; sp = r + r * r2 * sp;
    double cp = 2.0876756987868098979e-9; cp = cp * r2 - 2.7557319223985890653e-7; cp = cp * r2 + 2.4801587301587301566e-5; cp = cp * r2 - 1.3888888888888889419e-3; cp = cp * r2 + 4.1666666666666664354e-2; cp = cp * r2 - 0.5; cp = 1.0 + r2 * cp;
    const int qd = ((int)(long long)kq) & 3;
    const double cs = (qd & 1) ? sp : cp, sn = (qd & 1) ? cp : sp;
    c = (float)((qd == 1 || qd == 2) ? -cs : cs); s = (float)((qd >= 2) ? -sn : sn);
}

constexpr int NPL = 9;
constexpr int N_PHASES = 1 + DEPTH * NPL + 1;

__global__ void __launch_bounds__(NWAVES * 64, 2) fwd(Args args) {
    extern __shared__ __attribute__((aligned(16))) unsigned char lds[];
    Frame F;
    F.lds = (LAS unsigned char*)lds; F.MISC = (volatile LAS unsigned*)(F.lds + MISC_OFF);
    F.tid = threadIdx.x; F.lane = F.tid & 63; F.wave = __builtin_amdgcn_readfirstlane(F.tid >> 6);
    F.G = gridDim.x; { const int bx = blockIdx.x; F.vcu = (F.G % 8 == 0) ? (bx % 8) * (F.G / 8) + bx / 8 : bx; }
    unsigned char* ws = args.ws;
    F.ctl = (gu32*)(ws + WS_CTL);
    for (int u = F.tid; u < (LDS_BYTES - LDSCTL_OFF) / 4; u += NWAVES * 64) ((LAS unsigned*)(F.lds + LDSCTL_OFF))[u] = 0u;
    __syncthreads();
    const int lo = args.ph_lo, hi = args.ph_hi;
    const bool use_bar = (hi - lo) > 1;
    XcdBarrier bar; bar.bar = (unsigned*)(F.ctl + CW_BAR); bar.x = 0; bar.st = nullptr;
    if (use_bar) bar = xcd_barrier_post((unsigned*)(F.ctl + CW_BAR), F.MISC + 8);
#define PH_IN(id) (lo <= (id) && (id) < hi)
#define PH_END(id) do { if ((id) + 1 < hi) xcd_barrier(bar); } while (0)

    const float* x = (const float*)args.in[I_X]; const int* pos = (const int*)args.in[I_POS];
    float* h = args.out;
    bf16* hb = (bf16*)(ws + WS_HB); bf16* qb = (bf16*)(ws + WS_Q); bf16* kb = (bf16*)(ws + WS_K); bf16* vb = (bf16*)(ws + WS_V);
    bf16* zb = (bf16*)(ws + WS_Z); bf16* gb = (bf16*)(ws + WS_G); bf16* yb = (bf16*)(ws + WS_Y); bf16* mgb = (bf16*)(ws + WS_MG);
    bf16* actb = (bf16*)(ws + WS_ACT); float* tb = (float*)(ws + WS_T);
    float* cs = (float*)(ws + WS_CS); float* rstd1 = (float*)(ws + WS_RSTD1); float* rstd2 = (float*)(ws + WS_RSTD2); float* mu = (float*)(ws + WS_MU); float* rstdv = (float*)(ws + WS_RSTDV);
    const int gw = F.vcu * NWAVES + F.wave, NGW = F.G * NWAVES, lane = F.lane;

    if (PH_IN(0)) {
        LAS float* scr = (LAS float*)(F.lds + F.wave * 16384);
        constexpr int I_IN = (DM / 64) * (INW / 32), I_AB = (AW / 64) * (DM / 32), I_SB = (SGUW / 64) * (DM / 32), I_OUT = (DM / 64) * (DM / 32), I_GU = (DM / 64) * (2 * DFF / 32), I_DN = (DFF / 64) * (DM / 32);
        constexpr int I_LAYER = I_IN + I_AB + I_SB + I_OUT + I_GU + I_DN;
        for (int it = gw; it < DEPTH * I_LAYER; it += NGW) {
            const int l = it / I_LAYER; int r = it % I_LAYER; unsigned char* wl = ws + WS_W + (size_t)l * W_LAYER;
            if (r < I_IN) { transpose_item((const float*)args.in[I_WIN] + (size_t)l * DM * INW, DM, INW, (bf16*)(wl + WL_IN), (const float*)args.in[I_N1G] + l * DM, 0, scr, r, lane); continue; } r -= I_IN;
            if (r < I_AB) { transpose_item((const float*)args.in[I_WAB] + (size_t)l * AW * DM, AW, DM, (bf16*)(wl + WL_AB), nullptr, 0, scr, r, lane); continue; } r -= I_AB;
            if (r < I_SB) { transpose_item((const float*)args.in[I_WSB] + (size_t)l * SGUW * DM, SGUW, DM, (bf16*)(wl + WL_SB), nullptr, 0, scr, r, lane); continue; } r -= I_SB;
            if (r < I_OUT) { transpose_item((const float*)args.in[I_WOUT] + (size_t)l * DM * DM, DM, DM, (bf16*)(wl + WL_OUT), nullptr, 0, scr, r, lane); continue; } r -= I_OUT;
            if (r < I_GU) { transpose_item((const float*)args.in[I_WGU] + (size_t)l * DM * 2 * DFF, DM, 2 * DFF, (bf16*)(wl + WL_GU), (const float*)args.in[I_N2G] + l * DM, 1, scr, r, lane); continue; } r -= I_GU;
            transpose_item((const float*)args.in[I_WDN] + (size_t)l * DFF * DM, DFF, DM, (bf16*)(wl + WL_DN), nullptr, 0, scr, r, lane);
        }
        for (int m = gw; m < M; m += NGW) {
            const GAS f32x4* xr = (const GAS f32x4*)(x + (size_t)m * DM) + lane; GAS f32x4* hr = (GAS f32x4*)(h + (size_t)m * DM) + lane; GAS v2u* br = (GAS v2u*)(hb + (size_t)m * DM) + lane;
#pragma unroll
            for (int j = 0; j < 8; ++j) { const f32x4 v = xr[64 * j]; hr[64 * j] = v; br[64 * j] = (v2u){pk2(v.x, v.y), pk2(v.z, v.w)}; }
        }
        for (int i = (blockIdx.x * NWAVES * 64 + F.tid); i < M * 8; i += F.G * NWAVES * 64) {
            const int m = i >> 3, f = i & 7;
            const float invf[8] = {1.0f, 0.1939227432012558f, 0.03760603070259094f, 0.007292664609849453f, 0.0014142135623842478f, 0.00027424818836152554f, 5.318296098266728e-05f, 1.0313386155758053e-05f};
            float fr = invf[0];
#pragma unroll
            for (int q = 1; q < 8; ++q) fr = (f == q) ? invf[q] : fr;
            const float ang = (float)pos[m] * fr; float c, s; sincos_red(ang, c, s);
            cs[m * 16 + f] = c; cs[m * 16 + 8 + f] = s;
        }
        PH_END(0);
    }

    for (int l = 0; l < DEPTH; ++l) {
        const int pb = 1 + l * NPL;
        int tid_l = F.tid; asm volatile("" : "+v"(tid_l));
        const int lane = tid_l & 63, tidl = tid_l;
        unsigned char* wl = ws + WS_W + (size_t)l * W_LAYER;
        if (PH_IN(pb + 0)) {
            for (int m = gw; m < M; m += NGW) { const GAS f32x4* hr = (const GAS f32x4*)(h + (size_t)m * DM) + lane; float s = 0.f;
#pragma unroll
                for (int j = 0; j < 8; ++j) { const f32x4 v = hr[64 * j]; s += (v.x * v.x + v.y * v.y) + (v.z * v.z + v.w * v.w); }
                s = wave_sum(s); if (lane == 0) rstd1[m] = 1.0f / sqrtf(s * (1.0f / DM) + EPS); }
            PH_END(pb + 0);
        }
        if (PH_IN(pb + 1)) {
            pg8::Gemm g{hb, (const bf16*)(wl + WL_IN), M, INW, DM}; pg8::StaticOrder S; S.init(M, INW, F.G, (int)blockIdx.x);
            pg8::EpiInProj E{rstd1, (const float*)args.in[I_BIN] + l * INW, qb, kb, vb, zb, gb};
            pg8::gemm_phase<pg8::EpiInProj, pg8::StaticOrder, true, true>(F.lds, g, S, E);
            PH_END(pb + 1);
        }
        if (PH_IN(pb + 2)) {
            for (int i = (blockIdx.x * NWAVES * 64 + tidl); i < M * 20 * 8; i += F.G * NWAVES * 64) {
                const int f = i & 7, hh = (i >> 3) % 20, m = i / 160;
                bf16* p = (hh < 16) ? (qb + (size_t)m * AW + hh * HD) : (kb + (size_t)m * KVW + (hh - 16) * HD);
                const float c = cs[m * 16 + f], s = cs[m * 16 + 8 + f];
                const float t1 = bf2f(p[f]), t2 = bf2f(p[f + 8]);
                p[f] = (bf16)f2bf(t1 * c - t2 * s); p[f + 8] = (bf16)f2bf(t2 * c + t1 * s);
            }
            for (int m = gw; m < M; m += NGW) { const GAS v4u* zr = (const GAS v4u*)(zb + (size_t)m * 2 * SGUW + SGUW) + lane;
                float v[16];
#pragma unroll
                for (int j = 0; j < 2; ++j) { const v4u w = zr[64 * j]; v[8 * j + 0] = bflo(w.x); v[8 * j + 1] = bfhi(w.x); v[8 * j + 2] = bflo(w.y); v[8 * j + 3] = bfhi(w.y); v[8 * j + 4] = bflo(w.z); v[8 * j + 5] = bfhi(w.z); v[8 * j + 6] = bflo(w.w); v[8 * j + 7] = bfhi(w.w); }
                float s = 0.f;
#pragma unroll
                for (int j = 0; j < 16; ++j) s += v[j];
                const float mean = wave_sum(s) * (1.0f / SGUW); float q = 0.f;
#pragma unroll
                for (int j = 0; j < 16; ++j) { const float d = v[j] - mean; q += d * d; }
                q = wave_sum(q);
                if (lane == 0) { mu[m] = mean; rstdv[m] = 1.0f / sqrtf(q * (1.0f / SGUW) + EPS); } }
            PH_END(pb + 2);
        }
        if (PH_IN(pb + 3)) {
            const float* sinks = (const float*)args.in[I_SINKS] + l * NQH;
            for (int it = gw; it < M * NQH; it += NGW) {
                const int m = it >> 4, hq = it & 15, hk = hq >> 2, b = m / SEQ, t = m % SEQ;
                const GAS v4u* qp = (const GAS v4u*)(qb + (size_t)m * AW + hq * HD);
                float qf[64];
#pragma unroll
                for (int c = 0; c < 8; ++c) { const v4u w = qp[c]; qf[8 * c + 0] = bflo(w.x); qf[8 * c + 1] = bfhi(w.x); qf[8 * c + 2] = bflo(w.y); qf[8 * c + 3] = bfhi(w.y); qf[8 * c + 4] = bflo(w.z); qf[8 * c + 5] = bfhi(w.z); qf[8 * c + 6] = bflo(w.w); qf[8 * c + 7] = bfhi(w.w); }
                float sc[2]; bool vld[2];
#pragma unroll
                for (int kk = 0; kk < 2; ++kk) {
                    const int kpos = t - 127 + lane + 64 * kk; vld[kk] = kpos >= 0; const int kr = vld[kk] ? kpos : 0;
                    const GAS v4u* kp = (const GAS v4u*)(kb + (size_t)(b * SEQ + kr) * KVW + hk * HD); float a = 0.f;
#pragma unroll
                    for (int c = 0; c < 8; ++c) { const v4u w = kp[c];
                        a += qf[8 * c + 0] * bflo(w.x) + qf[8 * c + 1] * bfhi(w.x) + qf[8 * c + 2] * bflo(w.y) + qf[8 * c + 3] * bfhi(w.y) + qf[8 * c + 4] * bflo(w.z) + qf[8 * c + 5] * bfhi(w.z) + qf[8 * c + 6] * bflo(w.w) + qf[8 * c + 7] * bfhi(w.w); }
                    sc[kk] = vld[kk] ? a * 0.125f : -1e30f; }
                const float sink = sinks[hq];
                const float mx = fmaxf(wave_max(fmaxf(sc[0], sc[1])), sink);
                float p0 = vld[0] ? __expf(sc[0] - mx) : 0.f, p1 = vld[1] ? __expf(sc[1] - mx) : 0.f;
                const float den = wave_sum(p0 + p1) + __expf(sink - mx); const float inv = 1.0f / den; p0 *= inv; p1 *= inv;
                float o = 0.f;
                for (int k = 0; k < 64; ++k) { const float pk = __shfl(p0, k); const int kpos = t - 127 + k; if (kpos >= 0) o += pk * bf2f(vb[(size_t)(b * SEQ + kpos) * KVW + hk * HD + lane]); }
                for (int k = 0; k < 64; ++k) { const float pk = __shfl(p1, k); const int kpos = t - 63 + k; if (kpos >= 0) o += pk * bf2f(vb[(size_t)(b * SEQ + kpos) * KVW + hk * HD + lane]); }
                yb[(size_t)m * AW + hq * HD + lane] = (bf16)f2bf(o);
            }
            const float* lng = (const float*)args.in[I_LNG] + l * SGUW; const float* lnb = (const float*)args.in[I_LNB] + l * SGUW;
            const float* sw = (const float*)args.in[I_SGUW] + (size_t)l * SGUG * CHUNK * CHUNK; const float* sbias = (const float*)args.in[I_SGUB] + l * SGUG * CHUNK;
            bf16* ys = yb + (size_t)M * AW;
            for (int it = gw; it < M * 16; it += NGW) {
                const int m = it >> 4, c = (it & 15) * 64 + lane, g = c >> 7, tl = m & (CHUNK - 1), base = m - tl;
                const float lg = lng[c], lb = lnb[c]; float sv = sbias[g * CHUNK + tl]; const float* wrow = sw + ((size_t)g * CHUNK + tl) * CHUNK;
                for (int s = 0; s <= tl; ++s) { const float vv = bf2f(zb[(size_t)(base + s) * 2 * SGUW + SGUW + c]); const float vn = (vv - mu[base + s]) * rstdv[base + s] * lg + lb; sv += wrow[s] * vn; }
                const float uu = bf2f(zb[(size_t)m * 2 * SGUW + c]);
                ys[(size_t)m * SGUW + c] = (bf16)f2bf(uu * sv);
            }
            PH_END(pb + 3);
        }
        if (PH_IN(pb + 4)) {
            pg8::Gemm g{yb, (const bf16*)(wl + WL_AB), 2 * M, 2 * DM, AW}; pg8::PairOrder S; S.base.init(M, DM, F.G, (int)blockIdx.x);
            pg8::EpiGate E{gb, tb, mgb};
            pg8::gemm_phase<pg8::EpiGate, pg8::PairOrder, true, true>(F.lds, g, S, E);
            PH_END(pb + 4);
        }
        if (PH_IN(pb + 5)) {
            pg8::Gemm g{mgb, (const bf16*)(wl + WL_OUT), M, DM, DM}; pg8::StaticOrder S; S.init(M, DM, F.G, (int)blockIdx.x);
            pg8::EpiResid E{h, hb};
            pg8::gemm_phase<pg8::EpiResid, pg8::StaticOrder, true, true>(F.lds, g, S, E);
            PH_END(pb + 5);
        }
        if (PH_IN(pb + 6)) {
            for (int m = gw; m < M; m += NGW) { const GAS f32x4* hr = (const GAS f32x4*)(h + (size_t)m * DM) + lane; float s = 0.f;
#pragma unroll
                for (int j = 0; j < 8; ++j) { const f32x4 v = hr[64 * j]; s += (v.x * v.x + v.y * v.y) + (v.z * v.z + v.w * v.w); }
                s = wave_sum(s); if (lane == 0) rstd2[m] = 1.0f / sqrtf(s * (1.0f / DM) + EPS); }
            PH_END(pb + 6);
        }
        if (PH_IN(pb + 7)) {
            pg8::Gemm g{hb, (const bf16*)(wl + WL_GU), M, 2 * DFF, DM}; pg8::StaticOrder S; S.init(M, 2 * DFF, F.G, (int)blockIdx.x);
            pg8::EpiSwiglu E{rstd2, actb};
            pg8::gemm_phase<pg8::EpiSwiglu, pg8::StaticOrder, true, true>(F.lds, g, S, E);
            PH_END(pb + 7);
        }
        if (PH_IN(pb + 8)) {
            pg8::Gemm g{actb, (const bf16*)(wl + WL_DN), M, DM, DFF}; pg8::StaticOrder S; S.init(M, DM, F.G, (int)blockIdx.x);
            pg8::EpiResid E{h, hb};
            pg8::gemm_phase<pg8::EpiResid, pg8::StaticOrder, true, true>(F.lds, g, S, E);
            PH_END(pb + 8);
        }
    }
    if (PH_IN(N_PHASES - 1)) {
        const float* fg = (const float*)args.in[I_FG];
        for (int m = gw; m < M; m += NGW) { GAS f32x4* hr = (GAS f32x4*)(h + (size_t)m * DM) + lane; const GAS f32x4* gr = (const GAS f32x4*)fg + lane; f32x4 v[8]; float s = 0.f;
#pragma unroll
            for (int j = 0; j < 8; ++j) { v[j] = hr[64 * j]; s += (v[j].x * v[j].x + v[j].y * v[j].y) + (v[j].z * v[j].z + v[j].w * v[j].w); }
            const float rs = 1.0f / sqrtf(wave_sum(s) * (1.0f / DM) + EPS);
#pragma unroll
            for (int j = 0; j < 8; ++j) hr[64 * j] = v[j] * rs * gr[64 * j]; }
    }
#undef PH_IN
#undef PH_END
}

extern "C" void kernel_launch(void* const* d_in, const int* in_sizes, int n_in, void* d_out, int out_size, void* d_ws, size_t ws_size, hipStream_t stream) {
    static int grid = 0;
    if (grid == 0) {
        if (n_in != 17 || in_sizes[0] != M * DM || out_size != M * DM || ws_size < WS_END) { fprintf(stderr, "kernel_launch: unexpected shapes (n_in %d, in0 %d, out %d, ws %zu < %zu); nothing launched\n", n_in, n_in > 0 ? in_sizes[0] : -1, out_size, ws_size, (size_t)WS_END); grid = -1; return; }
        int dev = 0, cus = 0, per_cu = 0;
        if (hipGetDevice(&dev) != hipSuccess || hipDeviceGetAttribute(&cus, hipDeviceAttributeMultiprocessorCount, dev) != hipSuccess) { grid = -1; return; }
        if (hipFuncSetAttribute((const void*)fwd, hipFuncAttributeMaxDynamicSharedMemorySize, LDS_BYTES) != hipSuccess) { fprintf(stderr, "kernel_launch: hipFuncSetAttribute failed\n"); grid = -1; return; }
        if (hipOccupancyMaxActiveBlocksPerMultiprocessor(&per_cu, (const void*)fwd, NWAVES * 64, LDS_BYTES) != hipSuccess || per_cu < 1) fprintf(stderr, "kernel_launch: occupancy query reports %d\n", per_cu);
        (void)hipGetLastError();
        grid = cus;
    }
    if (grid < 0) return;
    if (hipMemsetAsync((char*)d_ws + WS_CTL, 0, CTL_ZERO_BYTES, stream) != hipSuccess) return;
    Args a{};
    for (int i = 0; i < 17; ++i) a.in[i] = d_in[i];
    a.out = (float*)d_out; a.ws = (unsigned char*)d_ws; a.li = 0; a.pad = 0;
#if MK_ONE_LAUNCH
    a.ph_lo = 0; a.ph_hi = N_PHASES;
    hipLaunchKernelGGL(fwd, dim3(grid), dim3(NWAVES * 64), LDS_BYTES, stream, a);
#else
    for (int p = 0; p < N_PHASES; ++p) { a.ph_lo = p; a.ph_hi = p + 1; hipLaunchKernelGGL(fwd, dim3(grid), dim3(NWAVES * 64), LDS_BYTES, stream, a); }
#endif
}
```

```cpp
#include <hip/hip_runtime.h>
#include <cstdio>
#include <cstdint>
__device__ __forceinline__ int lane_here() { unsigned z = 0u; asm volatile("" : "+v"(z)); return (int)__builtin_amdgcn_mbcnt_hi(~0u, __builtin_amdgcn_mbcnt_lo(~0u, z)); }
namespace pg8 {
#define PG8_LAS __attribute__((address_space(3)))
typedef unsigned short bf16_t;
typedef short bf16x8 __attribute__((ext_vector_type(8)));
typedef float f32x4 __attribute__((ext_vector_type(4)));
typedef unsigned u32x4 __attribute__((ext_vector_type(4)));
constexpr int BM = 256, BK = 64, HALF = 128, HTB = HALF * BK * 2  , STAGE_BYTES = 8 * HTB, NXCD = 8, WGM = 8;

__host__ __device__ __forceinline__ int lds_byte(int r, int c) { const int st = (r >> 4) * 2 + (c >> 5), rr = r & 15, cc = c & 31, ob = rr * 64 + cc * 2; return st * 1024 + (ob ^ (((ob >> 9) & 1) << 5)); }
__host__ __device__ __forceinline__ void stage_rc(int b, int& R, int& C) { const int st = b / 1024, sb = b % 1024, swz = sb ^ (((sb >> 9) & 1) << 5); R = (st >> 1) * 16 + swz / 64; C = (st & 1) * 32 + (swz % 64) / 2; }
__host__ __device__ __forceinline__ int perm32(int rho) { const int n = rho >> 4, i = rho & 15; return 8 * (i >> 2) + 4 * n + (i & 3); }

struct Unit { int pm, pn; };
struct Gemm { const bf16_t* A; const bf16_t* Bt; int M, N, K; };

struct StaticOrder {
    int nM, nN, nwg, G, c, wgm;
    __host__ __device__ void init(int M, int N, int G_, int c_, int wgm_ = WGM) { nM = M / BM; nN = N / BM; nwg = nM * nN; G = G_; c = c_; wgm = wgm_; }
    __host__ __device__ bool next(int i, Unit& u) const {
        const long L = (long)i * G + c; if (L >= nwg) return false;
        int wgid = (int)L; { const int q = nwg / NXCD, r = nwg % NXCD, xcd = wgid % NXCD, off = wgid / NXCD; wgid = (xcd < r ? xcd * (q + 1) : r * (q + 1) + (xcd - r) * q) + off; }
        const int nig = wgm * nN, gid = wgid / nig, fm = gid * wgm, gsz = (nM - fm) < wgm ? (nM - fm) : wgm;
        u.pm = fm + ((wgid % nig) % gsz); u.pn = (wgid % nig) / gsz; return true;
    }
    __device__ __forceinline__ void a_ready(const Unit&) const {}
    __device__ __forceinline__ void done(const Unit&) const {}
};

__device__ __forceinline__ unsigned cvt_pk_bf16(float lo, float hi) { unsigned r; asm volatile("v_cvt_pk_bf16_f32 %0, %1, %2" : "=v"(r) : "v"(lo), "v"(hi)); return r; }
typedef float f32x2 __attribute__((ext_vector_type(2)));
__device__ __forceinline__ f32x2 gelu_pk(f32x2 v) {
    const f32x2 av = __builtin_elementwise_abs(v), d = av * 0.2316418882f + 1.0f;
    f32x2 t; t.x = __builtin_amdgcn_rcpf(d.x); t.y = __builtin_amdgcn_rcpf(d.y);
    f32x2 q = t * 0.5307027145f + (-0.7265760135f); q = q * t + 0.7107068705f; q = q * t + (-0.142248368f); q = q * t + 0.127414796f; q = q * t;
    const f32x2 s = (v * v) * (-0.72134752044f);
    f32x2 e; e.x = __builtin_amdgcn_exp2f(s.x); e.y = __builtin_amdgcn_exp2f(s.y);
    const f32x2 m = v * (q * e), r = v - m;
    f32x2 o; o.x = v.x < 0.f ? m.x : r.x; o.y = v.y < 0.f ? m.y : r.y; return o;
}

template <int ACT  > struct EpiBf16 {
    static constexpr bool PERM = true, AFTER_DRAIN = false; static constexpr int MID_T = 0; static constexpr bool BLOCKED = false; static_assert(ACT == 0 || ACT == 1, "EpiBf16: ACT is 0 (none) or 1 (gelu_pk)");
    bf16_t* O; int ldc; const float* bias; int split_cols; size_t split_stride; float scale0;
    __device__ __forceinline__ void operator()(const f32x4 (&acc)[2][2][4][2], const Unit& u, int wr, int wc, int fr, int fq) const {
        const int row0 = u.pm * BM + wr * 64 + fr; int colt = u.pn * BM; bf16_t* base = O;
        float sc = 1.f; if (split_cols) { const int t = colt / split_cols; base += (size_t)t * split_stride; colt -= t * split_cols; if (t == 0) sc = scale0; }
        const int col0 = colt + wc * 32 + 8 * fq, bcol0 = u.pn * BM + wc * 32 + 8 * fq;
        f32x4 bv[2][2];
#pragma unroll
        for (int bj = 0; bj < 2; ++bj)
#pragma unroll
            for (int n = 0; n < 2; ++n) bv[bj][n] = bias ? *(const f32x4*)(bias + bcol0 + bj * HALF + 4 * n) : (f32x4){0.f, 0.f, 0.f, 0.f};
#pragma unroll
        for (int ai = 0; ai < 2; ++ai)
#pragma unroll
            for (int m = 0; m < 4; ++m) { bf16_t* rowp = base + (size_t)(row0 + ai * HALF + m * 16) * ldc + col0;
#pragma unroll
                for (int bj = 0; bj < 2; ++bj) { f32x4 v0 = acc[ai][bj][m][0] + bv[bj][0], v1 = acc[ai][bj][m][1] + bv[bj][1];
                    if (ACT == 1) { f32x2 a = gelu_pk((f32x2){v0[0], v0[1]}), b = gelu_pk((f32x2){v0[2], v0[3]}), c = gelu_pk((f32x2){v1[0], v1[1]}), d = gelu_pk((f32x2){v1[2], v1[3]});
                        v0 = (f32x4){a.x, a.y, b.x, b.y}; v1 = (f32x4){c.x, c.y, d.x, d.y}; }
                    v0 = v0 * sc; v1 = v1 * sc; u32x4 w; w.x = cvt_pk_bf16(v0[0], v0[1]); w.y = cvt_pk_bf16(v0[2], v0[3]); w.z = cvt_pk_bf16(v1[0], v1[1]); w.w = cvt_pk_bf16(v1[2], v1[3]);
                    *(u32x4*)(rowp + bj * HALF) = w; } }
    }
};


template <class Epi, class Sched, bool ALIGN_EPI = false, bool SP2 = false>
__device__ __forceinline__ void gemm_phase(PG8_LAS unsigned char* lds, const Gemm g, const Sched& S, const Epi& E, const int wave_id) {
    int tid_ = lane_here() + 64 * wave_id; asm volatile("" : "+v"(tid_));
    const int tid = tid_, wid = __builtin_amdgcn_readfirstlane(tid >> 6), lane = tid & 63, wr = wid >> 2, wc = wid & 3, fr = lane & 15, fq = lane >> 4;
    const int K = g.K, nt = K / BK;
    unsigned voffA[2], voffB[2];
#pragma unroll
    for (int i = 0; i < 2; ++i) { int R, C; stage_rc(tid * 16 + i * 8192, R, C); const int Rb = Epi::PERM ? ((R & ~31) + perm32(R & 31)) : R;
        (void)R; (void)C; (void)Rb; voffA[i] = (unsigned)(tid * 16 + i * 8192); voffB[i] = voffA[i]; }
    const unsigned kstep = (unsigned)(HALF * BK * 2);
    const unsigned hstep = (unsigned)HALF * (unsigned)K * 2u;
    const unsigned tstep = 2u * hstep;
    const unsigned ldsw = (unsigned)wid * 1024u;
    const int aoff = lds_byte(wr * 64 + fr, fq * 8), boff = lds_byte(wc * 32 + fr, fq * 8);
#define PG8_SA(b, h) (((b) * 2 + (h)) * HTB)
#define PG8_SB(b, h) ((4 + (b) * 2 + (h)) * HTB)
    const __amdgpu_buffer_rsrc_t srdA = __builtin_amdgcn_make_buffer_rsrc((void*)g.A, (short)0, (int)((size_t)g.M * (size_t)K * 2), 0x00020000);
    const __amdgpu_buffer_rsrc_t srdB = __builtin_amdgcn_make_buffer_rsrc((void*)g.Bt, (short)0, (int)((size_t)g.N * (size_t)K * 2), 0x00020000);
    const unsigned ldsb = __builtin_amdgcn_readfirstlane((unsigned)(__UINTPTR_TYPE__)lds);
#define PG8_STAGEX(srd, bufoff, off32, voff) do { _Pragma("unroll") for (int _i = 0; _i < 2; ++_i) { const unsigned m0_ = ldsb + (unsigned)(bufoff) + ldsw + (unsigned)(_i * 8192); const unsigned so_ = (unsigned)(off32); \
        asm volatile("s_mov_b32 m0, %0\n\ts_nop 0\n\tbuffer_load_dwordx4 %1, %2, %3 offen lds" :: "s"(m0_), "v"((voff)[_i]), "s"(srd), "s"(so_) : "m0", "memory"); } } while (0)
#define PG8_STAGEA(bufoff, off32, voff) PG8_STAGEX(srdA, bufoff, off32, voff)
#define PG8_STAGEB(bufoff, off32, voff) PG8_STAGEX(srdB, bufoff, off32, voff)
#define PG8_LDA(dst, b, h) do { _Pragma("unroll") for (int m = 0; m < 4; ++m) _Pragma("unroll") for (int k = 0; k < 2; ++k) dst[m][k] = *(const PG8_LAS bf16x8*)(lds + PG8_SA(b, h) + aoff + m * 2048 + k * 1024); } while (0)
#define PG8_LDB(dst, b, h) do { _Pragma("unroll") for (int n = 0; n < 2; ++n) _Pragma("unroll") for (int k = 0; k < 2; ++k) dst[n][k] = *(const PG8_LAS bf16x8*)(lds + PG8_SB(b, h) + boff + n * 2048 + k * 1024); } while (0)
#define PG8_MMA(ai, bj, At, Bt) do { __builtin_amdgcn_s_setprio(1); _Pragma("unroll") for (int m = 0; m < 4; ++m) _Pragma("unroll") for (int n = 0; n < 2; ++n) _Pragma("unroll") for (int k = 0; k < 2; ++k) \
        acc[ai][bj][m][n] = __builtin_amdgcn_mfma_f32_16x16x32_bf16(Bt[n][k], At[m][k], acc[ai][bj][m][n], 0, 0, 0); __builtin_amdgcn_s_setprio(0); } while (0)
#define PG8_WAIT_V(n) asm volatile("s_waitcnt vmcnt(" #n ")" ::: "memory")
#define PG8_WAIT_L(n) asm volatile("s_waitcnt lgkmcnt(" #n ")" ::: "memory")
#define PG8_BAR __builtin_amdgcn_s_barrier()
#define PG8_SCHED __builtin_amdgcn_sched_barrier(0)
    Unit cur, nxt; int ui = 0;
    if (!S.next(0, cur)) return;
    f32x4 acc[2][2][4][2];
#pragma unroll
    for (int a = 0; a < 2; ++a)
#pragma unroll
        for (int b = 0; b < 2; ++b)
#pragma unroll
            for (int m = 0; m < 4; ++m)
#pragma unroll
                for (int n = 0; n < 2; ++n) acc[a][b][m][n] = (f32x4){0.f, 0.f, 0.f, 0.f};
    bf16x8 At[4][2], B0[2][2], B1[2][2];
    unsigned cA = (unsigned)cur.pm * tstep, cB = (unsigned)cur.pn * tstep;
    S.a_ready(cur);
    if constexpr (SP2) {
        PG8_STAGEB(PG8_SB(0, 0), cB, voffB); PG8_STAGEB(PG8_SB(0, 1), cB + hstep, voffB); PG8_STAGEA(PG8_SA(0, 0), cA, voffA); PG8_STAGEA(PG8_SA(0, 1), cA + hstep, voffA);
        if (wr == 1) PG8_BAR;
        PG8_WAIT_V(2); PG8_BAR;
        PG8_STAGEB(PG8_SB(1, 0), cB + kstep, voffB); PG8_STAGEA(PG8_SA(1, 0), cA + kstep, voffA); PG8_STAGEB(PG8_SB(1, 1), cB + hstep + kstep, voffB);
        PG8_WAIT_V(6); PG8_BAR;
    } else {
        PG8_STAGEB(PG8_SB(0, 0), cB, voffB); PG8_STAGEA(PG8_SA(0, 0), cA, voffA); PG8_STAGEB(PG8_SB(0, 1), cB + hstep, voffB); PG8_STAGEA(PG8_SA(0, 1), cA + hstep, voffA);
        if (wr == 1) PG8_BAR;
        PG8_WAIT_V(4); PG8_BAR;
        PG8_STAGEB(PG8_SB(1, 0), cB + kstep, voffB); PG8_STAGEA(PG8_SA(1, 0), cA + kstep, voffA); PG8_STAGEB(PG8_SB(1, 1), cB + hstep + kstep, voffB);
        PG8_WAIT_V(6); PG8_BAR;
    }
    for (;;) {
        const bool has_next = S.next(ui + 1, nxt);
        const unsigned nA = has_next ? (unsigned)nxt.pm * tstep : cA, nB = has_next ? (unsigned)nxt.pn * tstep : cB;
        for (int t = 0; t < nt; t += 2) {
            if constexpr (Epi::MID_T > 0) { if (t == Epi::MID_T) E.mid(acc, cur, wr, wc, fr, fq); }
            const bool last = (t == nt - 2);
            const unsigned a1 = cA + (unsigned)(t + 1) * kstep;
            const unsigned a2 = last ? nA : cA + (unsigned)(t + 2) * kstep, b2 = last ? nB : cB + (unsigned)(t + 2) * kstep;
            const unsigned a3 = a2 + kstep, b3 = b2 + kstep;
            if (last && has_next) S.a_ready(nxt);
            if constexpr (SP2) {
            PG8_LDB(B0, 0, 0); PG8_LDB(B1, 0, 1); PG8_SCHED; PG8_LDA(At, 0, 0); PG8_STAGEA(PG8_SA(1, 1), a1 + hstep, voffA);
            PG8_WAIT_V(8); PG8_WAIT_L(0); PG8_BAR; PG8_MMA(0, 0, At, B0); PG8_MMA(0, 1, At, B1); PG8_BAR; PG8_SCHED;
            PG8_LDA(At, 0, 1); PG8_STAGEB(PG8_SB(0, 0), b2, voffB); PG8_STAGEB(PG8_SB(0, 1), b2 + hstep, voffB); PG8_STAGEA(PG8_SA(0, 0), a2, voffA);
            PG8_WAIT_V(8); PG8_WAIT_L(0); PG8_BAR; PG8_MMA(1, 0, At, B0); PG8_MMA(1, 1, At, B1); PG8_BAR; PG8_SCHED;
            PG8_LDB(B0, 1, 0); PG8_LDB(B1, 1, 1); PG8_SCHED; PG8_LDA(At, 1, 0); PG8_STAGEA(PG8_SA(0, 1), a2 + hstep, voffA);
            PG8_WAIT_V(8); PG8_WAIT_L(0); PG8_BAR; PG8_MMA(0, 0, At, B0); PG8_MMA(0, 1, At, B1); PG8_BAR; PG8_SCHED;
            PG8_LDA(At, 1, 1); PG8_STAGEB(PG8_SB(1, 0), b3, voffB); PG8_STAGEB(PG8_SB(1, 1), b3 + hstep, voffB); PG8_STAGEA(PG8_SA(1, 0), a3, voffA);
            PG8_WAIT_V(8); PG8_WAIT_L(0); PG8_BAR; PG8_MMA(1, 0, At, B0); PG8_MMA(1, 1, At, B1); PG8_BAR; PG8_SCHED;
            } else {
            PG8_LDB(B0, 0, 0); PG8_SCHED; PG8_LDA(At, 0, 0); PG8_STAGEA(PG8_SA(1, 1), a1 + hstep, voffA);
            PG8_WAIT_L(8); PG8_BAR; PG8_WAIT_L(0); PG8_MMA(0, 0, At, B0); PG8_BAR; PG8_SCHED;
            PG8_LDB(B1, 0, 1); PG8_STAGEB(PG8_SB(0, 0), b2, voffB);
            PG8_BAR; PG8_WAIT_L(0); PG8_MMA(0, 1, At, B1); PG8_BAR;
            PG8_LDA(At, 0, 1); PG8_STAGEA(PG8_SA(0, 0), a2, voffA);
            PG8_BAR; PG8_WAIT_L(0); PG8_MMA(1, 0, At, B0); PG8_BAR; PG8_SCHED;
            PG8_STAGEB(PG8_SB(0, 1), b2 + hstep, voffB);
            PG8_WAIT_V(6); PG8_BAR; PG8_MMA(1, 1, At, B1); PG8_BAR;
            PG8_LDB(B0, 1, 0); PG8_SCHED; PG8_LDA(At, 1, 0); PG8_STAGEA(PG8_SA(0, 1), a2 + hstep, voffA);
            PG8_WAIT_L(8); PG8_BAR; PG8_WAIT_L(0); PG8_MMA(0, 0, At, B0); PG8_BAR; PG8_SCHED;
            PG8_LDB(B1, 1, 1); PG8_STAGEB(PG8_SB(1, 0), b3, voffB);
            PG8_BAR; PG8_WAIT_L(0); PG8_MMA(0, 1, At, B1); PG8_BAR;
            PG8_LDA(At, 1, 1); PG8_STAGEA(PG8_SA(1, 0), a3, voffA);
            PG8_BAR; PG8_WAIT_L(0); PG8_MMA(1, 0, At, B0); PG8_BAR; PG8_SCHED;
            PG8_STAGEB(PG8_SB(1, 1), b3 + hstep, voffB);
            PG8_WAIT_V(6); PG8_BAR; PG8_MMA(1, 1, At, B1); PG8_BAR;
            }
        }
        if constexpr (ALIGN_EPI) { if (wr == 0) PG8_BAR; }
        if constexpr (!Epi::AFTER_DRAIN) { E(acc, cur, wr, wc, fr, fq); S.done(cur); }
        if (!has_next) break;
#pragma unroll
        for (int a = 0; a < 2; ++a)
#pragma unroll
            for (int b = 0; b < 2; ++b)
#pragma unroll
                for (int m = 0; m < 4; ++m)
#pragma unroll
                    for (int n = 0; n < 2; ++n) acc[a][b][m][n] = (f32x4){0.f, 0.f, 0.f, 0.f};
        cur = nxt; cA = nA; cB = nB; ++ui;
        if constexpr (ALIGN_EPI) { if (wr == 1) PG8_BAR; }
    }
    PG8_WAIT_V(0);
    if constexpr (!ALIGN_EPI) { if (wr == 0) PG8_BAR; }
    PG8_BAR;
    if constexpr (Epi::AFTER_DRAIN) { E.fused(acc, cur, wr, wc, fr, fq, lds, wid, lane); S.done(cur); }
#undef PG8_SA
#undef PG8_SB
#undef PG8_STAGEX
#undef PG8_STAGEA
#undef PG8_STAGEB
#undef PG8_LDA
#undef PG8_LDB
#undef PG8_MMA
#undef PG8_WAIT_V
#undef PG8_WAIT_L
#undef PG8_BAR
#undef PG8_SCHED
}
}

#define GAS __attribute__((address_space(1)))
#define LAS __attribute__((address_space(3)))
typedef unsigned short bf16;
typedef unsigned v4u __attribute__((ext_vector_type(4)));
typedef float f32x4 __attribute__((ext_vector_type(4)));
typedef short bf16x8 __attribute__((ext_vector_type(8)));
typedef GAS unsigned gu32;
typedef GAS unsigned long long gu64;
#define RLX_AGENT __ATOMIC_RELAXED, __HIP_MEMORY_SCOPE_AGENT
#define LDS_WAIT() asm volatile("s_waitcnt lgkmcnt(0)" ::: "memory")
#define VM_WAIT() asm volatile("s_waitcnt vmcnt(0)" ::: "memory")
__device__ __forceinline__ unsigned long long rt() { return __builtin_amdgcn_s_memrealtime(); }
__device__ __forceinline__ unsigned f2bf(float f) { unsigned u = __builtin_bit_cast(unsigned, f); return (u + 0x7fffu + ((u >> 16) & 1u)) >> 16; }
__device__ __forceinline__ unsigned pk2(float lo, float hi) { return f2bf(lo) | (f2bf(hi) << 16); }

#define XB_TMO      128
#define XB_XCNT(j)  (256  + 64 * (j))
#define XB_XSUB(j)  (1280 + 64 * (j))
#define XB_XGEN(j)  (2304 + 64 * (j))
#define XB_TOP      3328
#define XB_TOPGEN   3392
#define XCD_BAR_WORDS 3456
#define XB_SPIN_CAP (1u << 18)

__device__ __forceinline__ unsigned xb_ld(unsigned* p)              { return __hip_atomic_load(p, __ATOMIC_RELAXED, __HIP_MEMORY_SCOPE_AGENT); }
__device__ __forceinline__ unsigned xb_add(unsigned* p, unsigned v) { return __hip_atomic_fetch_add(p, v, __ATOMIC_RELAXED, __HIP_MEMORY_SCOPE_AGENT); }
__device__ __forceinline__ unsigned xb_xcc_id() { return (unsigned)__builtin_amdgcn_s_getreg((3 << 11) | 20) & 0xFu; }
#define XB_SPIN(cond, bar) do { unsigned _sp = 0; while (cond) { __builtin_amdgcn_s_sleep(1); \
    if ((++_sp & 255u) == 0u) { if (xb_ld(&(bar)[XB_TMO])) break; if (_sp > XB_SPIN_CAP) { atomicAdd(&(bar)[XB_TMO], 1u); break; } } } } while (0)

struct XcdBarrier {
    unsigned* bar; unsigned x;
    volatile LAS unsigned* st;
};

__device__ __forceinline__ XcdBarrier xcd_barrier_post(unsigned* bar, volatile LAS unsigned* st) {
    XcdBarrier b; b.bar = bar; b.x = xb_xcc_id(); b.st = st;
    if (threadIdx.x == 0) (void)xb_add(&bar[XB_XCNT(b.x)], 1u);
    return b;
}
__device__ __forceinline__ void xcd_barrier_complete(unsigned* bar, unsigned x, unsigned& nloc, unsigned& nx) {
    const unsigned G = gridDim.x * gridDim.y * gridDim.z;
    unsigned sum, cnt, mine, sp = 0u;
    for (;;) {
        sum = 0u; cnt = 0u; mine = 0u;
#pragma unroll
        for (unsigned j = 0; j < 16; ++j) { const unsigned c = xb_ld(&bar[XB_XCNT(j)]); sum += c; cnt += (c > 0u) ? 1u : 0u; mine = (j == x) ? c : mine; }
        if (sum == G) break;
        __builtin_amdgcn_s_sleep(1);
        if ((++sp & 255u) == 0u) { if (xb_ld(&bar[XB_TMO])) break; if (sp > XB_SPIN_CAP) { atomicAdd(&bar[XB_TMO], 1u); break; } }
    }
    nloc = mine > 0u ? mine : 1u; nx = cnt > 0u ? cnt : 1u;
}

__device__ __forceinline__ void xcd_barrier(const XcdBarrier& b, const bool xb_wave0) {
    asm volatile("s_waitcnt vmcnt(0)" ::: "memory");
    __syncthreads();
    if (xb_wave0 && lane_here() == 0) {
        unsigned* bar = b.bar;
        __builtin_amdgcn_s_waitcnt(0);
        unsigned nloc = b.st[0], nx = b.st[1];
        if (nloc == 0u) { xcd_barrier_complete(bar, b.x, nloc, nx); b.st[0] = nloc; b.st[1] = nx; }
        const unsigned old = xb_add(&bar[XB_XSUB(b.x)], 1u);
        const unsigned gen = old / nloc;
        if (old + 1u == (gen + 1u) * nloc) {
            __builtin_amdgcn_fence(__ATOMIC_RELEASE, "agent");
            asm volatile("s_waitcnt vmcnt(0)" ::: "memory");
            const unsigned og = xb_add(&bar[XB_TOP], 1u);
            const unsigned tg = og / nx;
            if (og + 1u == (tg + 1u) * nx) xb_add(&bar[XB_TOPGEN], 1u);
            else XB_SPIN(xb_ld(&bar[XB_TOPGEN]) == tg, bar);
            __builtin_amdgcn_fence(__ATOMIC_ACQUIRE, "agent");
            xb_add(&bar[XB_XGEN(b.x)], 1u);
            asm volatile("s_waitcnt vmcnt(0)" ::: "memory");
        } else {
            XB_SPIN(xb_ld(&bar[XB_XGEN(b.x)]) == gen, bar);
            __builtin_amdgcn_fence(__ATOMIC_ACQUIRE, "agent");
            asm volatile("s_waitcnt vmcnt(0)" ::: "memory");
        }
    }
    __syncthreads();
}


constexpr int NWAVES = 8;
#ifndef MK_ONE_LAUNCH
#define MK_ONE_LAUNCH 1
#endif
constexpr int BATCH = 2, SEQ = 8192, M = BATCH * SEQ, DM = 2048, DEPTH = 4;
constexpr int NQH = 16, NKVH = 4, HD = 64, AW = 1024, KVW = 256, WIN = 128;
constexpr int SGUW = 1024, SGUG = 8, CHUNK = 128, DFF = 5632;
constexpr int OFF_Q = 0, OFF_K = 1024, OFF_V = 1280, OFF_Z = 1536, OFF_G = 3584, INW = 7680;
constexpr float EPS = 1e-5f;

constexpr size_t MiB = 1u << 20;
constexpr size_t WS_CTL = 0, CTL_ZERO_BYTES = 4 * MiB;
constexpr size_t WS_SSQ = 1 * MiB;
constexpr size_t WS_ZST = 2 * MiB + 512 * 1024;
constexpr size_t WS_CS = 4 * MiB;
constexpr size_t WS_W = 8 * MiB, W_LAYER = 112 * MiB;
constexpr size_t WL_IN = 0, WL_AB = 30 * MiB, WL_SB = 34 * MiB, WL_OUT = 38 * MiB, WL_GU = 46 * MiB, WL_DN = 90 * MiB;
constexpr size_t WS_HB = WS_W + DEPTH * W_LAYER;
constexpr size_t WS_Q = WS_HB + 64 * MiB, WS_K = WS_Q + 32 * MiB, WS_V = WS_K + 8 * MiB;
constexpr size_t WS_Z = WS_V + 8 * MiB;
constexpr size_t WS_G = WS_Z + 64 * MiB;
constexpr size_t WS_Y = WS_G + 128 * MiB;
constexpr size_t WS_MG = WS_Y + 64 * MiB;
constexpr size_t WS_ACT = WS_MG + 64 * MiB;
constexpr size_t WS_T = WS_ACT;
constexpr size_t WS_END = WS_ACT + 176 * MiB;
static_assert((size_t)INW * DM * 2 <= 30 * MiB && (size_t)2 * DM * DFF * 2 <= 44 * MiB && (size_t)DM * DFF * 2 <= 22 * MiB, "weight map");
static_assert((size_t)M * DFF * 2 <= 176 * MiB && (size_t)M * DM * 4 <= 176 * MiB, "act map");
constexpr int CW_BAR = 4096;
constexpr size_t WS_SGUWM = 5 * MiB;
constexpr int P2_KROW = 144, P2_VROW = 528, P2_SROW = 272, P2_K = 0, P2_V = 256 * P2_KROW, P2_LN = 72 * 1024, P2_WM = 76 * 1024;

constexpr int RING_BYTES = 131072, LDS_BYTES = 147456, LDSCTL_OFF = LDS_BYTES - 1024, MISC_OFF = LDSCTL_OFF + 320;

typedef unsigned v2u __attribute__((ext_vector_type(2)));
typedef float f32x2 __attribute__((ext_vector_type(2)));
__device__ __forceinline__ float bf2f(unsigned h) { return __builtin_bit_cast(float, h << 16); }
__device__ __forceinline__ float bflo(unsigned w) { return __builtin_bit_cast(float, w << 16); }
__device__ __forceinline__ float bfhi(unsigned w) { return __builtin_bit_cast(float, w & 0xffff0000u); }
__device__ __forceinline__ float wave_sum(float v) {
#pragma unroll
    for (int o = 1; o < 64; o <<= 1) v += __shfl_xor(v, o);
    return v;
}
__device__ __forceinline__ float wave_max(float v) {
#pragma unroll
    for (int o = 1; o < 64; o <<= 1) v = fmaxf(v, __shfl_xor(v, o));
    return v;
}
constexpr double FX_SSQ = 1048576.0, FX_ZST = 4294967296.0;
__device__ __forceinline__ unsigned long long fx_enc(float v, double scale) { return (unsigned long long)(long long)((double)v * scale); }
__device__ __forceinline__ void fx_add(unsigned long long* p, float v, double scale) { __hip_atomic_fetch_add(p, fx_enc(v, scale), __ATOMIC_RELAXED, __HIP_MEMORY_SCOPE_AGENT); }
__device__ __forceinline__ float rstd_from_ssq(const unsigned long long* p) { const unsigned long long v = *p; const float f = (float)(unsigned)(v >> 32) * 4294967296.0f + (float)(unsigned)v;
    return __builtin_amdgcn_rsqf(f * (float)(1.0 / (FX_SSQ * 2048.0)) + 1e-5f); }
__device__ __forceinline__ float sigmoidf_(float x) { return __builtin_amdgcn_rcpf(1.0f + __builtin_amdgcn_exp2f(-1.4426950408889634f * x)); }

__device__ __forceinline__ size_t blk_idx(size_t r, int c, int cols) { return ((r >> 7) * (size_t)(cols >> 6) + (size_t)(c >> 6)) * 8192 + (size_t)(pg8::lds_byte((int)(r & 127), c & 63) >> 1); }
__device__ __forceinline__ unsigned epi_img_byte(int wr, int wc, int fr, int fq) { return (unsigned)((wc >> 1) * 16384 + (8 * wr + (wc & 1)) * 1024 + ((fr * 64 + 16 * fq) ^ ((fr >> 3) << 5))); }
struct rsrc_t { const char* p; };
__device__ __forceinline__ rsrc_t mk_rsrc(const void* p, size_t) { rsrc_t r; r.p = (const char*)p; return r; }
__device__ __forceinline__ v4u bld16(rsrc_t r, unsigned voff, unsigned soff) { const char* sb = r.p + soff; asm volatile("" : "+s"(sb)); return *(const GAS v4u*)((const GAS char*)sb + voff); }
__device__ __forceinline__ v2u bld8(rsrc_t r, unsigned voff, unsigned soff) { const char* sb = r.p + soff; asm volatile("" : "+s"(sb)); return *(const GAS v2u*)((const GAS char*)sb + voff); }
__device__ __forceinline__ void bst16nt(v4u v, rsrc_t r, unsigned voff, unsigned soff) { const char* sb = r.p + soff; asm volatile("" : "+s"(sb)); __builtin_nontemporal_store(v, (GAS v4u*)((GAS char*)sb + voff)); }
__device__ __forceinline__ void bst16(v4u v, rsrc_t r, unsigned voff, unsigned soff) { const char* sb = r.p + soff; asm volatile("" : "+s"(sb)); *(GAS v4u*)((GAS char*)sb + voff) = v; }
__device__ __forceinline__ float rstd_from_bits(v2u w) { const float f = (float)w.y * 4294967296.0f + (float)w.x; return __builtin_amdgcn_rsqf(f * (float)(1.0 / (FX_SSQ * 2048.0)) + 1e-5f); }
namespace pg8 {
typedef __bf16 bf16x2_t __attribute__((ext_vector_type(2)));
__device__ __forceinline__ unsigned cvtpk(float lo, float hi) { const f32x2 v = {lo, hi}; return __builtin_bit_cast(unsigned, __builtin_convertvector(v, bf16x2_t)); }
__device__ __forceinline__ v4u pack8(const f32x4 v0, const f32x4 v1) { v4u w; w.x = cvtpk(v0[0], v0[1]); w.y = cvtpk(v0[2], v0[3]); w.z = cvtpk(v1[0], v1[1]); w.w = cvtpk(v1[2], v1[3]); return w; }
#define PIN2(a, b) asm volatile("" : "+v"(a), "+v"(b))
__device__ __forceinline__ f32x4 unlo(const v4u w) { return (f32x4){bflo(w.x), bfhi(w.x), bflo(w.y), bfhi(w.y)}; }
__device__ __forceinline__ f32x4 unhi(const v4u w) { return (f32x4){bflo(w.z), bfhi(w.z), bflo(w.w), bfhi(w.w)}; }
struct EpiInProj {
    static constexpr bool PERM = true, AFTER_DRAIN = false; static constexpr int MID_T = 0; static constexpr bool BLOCKED = false;
    const unsigned long long* ssq; const float* bias; const float* cs; unsigned long long* zst; bf16_t *q, *k, *v, *z, *g;
    __device__ __forceinline__ void operator()(const f32x4 (&acc)[2][2][4][2], const Unit& u, int wr, int wc, int fr, int fq) const {
        const int colt = u.pn * BM;
        bf16_t* base; int ldc, cb, mode;
        if (colt < OFF_K) { base = q; ldc = AW; cb = colt; mode = 0; }
        else if (colt < OFF_V) { base = k; ldc = KVW; cb = colt - OFF_K; mode = 0; }
        else if (colt < OFF_Z) { base = v; ldc = KVW; cb = colt - OFF_V; mode = 0; }
        else if (colt < OFF_G) { base = z; ldc = 2 * SGUW; cb = colt - OFF_Z; mode = 1; }
        else { base = g; ldc = DM; cb = (colt - OFF_G) >> 1; mode = 2; }
        const bool rope = (colt < OFF_V) && ((wc & 1) == 0);
        const bool vstat = (mode == 1) && (cb >= SGUW);
        const rsrc_t ro = mk_rsrc(base, (size_t)M * ldc * (mode == 2 ? 4 : 2)), rq = mk_rsrc(ssq, (size_t)M * 8), rc = mk_rsrc(cs, (size_t)M * 64);
        const unsigned lrow = wr * 64 + fr, vo = (lrow * ldc + wc * 32 + 8 * fq) * 2u, vq = lrow * 8u, vc = lrow * 64u;
        const unsigned so = ((unsigned)u.pm * BM * ldc + cb) * 2u, sq = (unsigned)u.pm * BM * 8u, sc = (unsigned)u.pm * BM * 64u;
        const int bcol0 = (mode == 2 ? OFF_G + cb : colt) + wc * 32 + 8 * fq;
        f32x4 bv[2][2];
#pragma unroll
        for (int bj = 0; bj < 2; ++bj)
#pragma unroll
            for (int n = 0; n < 2; ++n) bv[bj][n] = *(const f32x4*)(bias + bcol0 + bj * (mode == 2 ? DM : HALF) + 4 * n);
        v2u sw[2][4];
#pragma unroll
        for (int ai = 0; ai < 2; ++ai)
#pragma unroll
            for (int m = 0; m < 4; ++m) sw[ai][m] = bld8(rq, vq, sq + (ai * HALF + m * 16) * 8u);
#pragma unroll
        for (int ai = 0; ai < 2; ++ai)
#pragma unroll
            for (int m = 0; m < 4; ++m) { const unsigned rofs = (ai * HALF + m * 16); const float rs = rstd_from_bits(sw[ai][m]);
                if (mode == 2) {
                    const float c1 = rs * -1.4426950408889634f; f32x4 rv[2], sv[2];
#pragma unroll
                    for (int n = 0; n < 2; ++n) {
                        f32x4 ea = acc[ai][0][m][n] * c1 + bv[0][n] * -1.4426950408889634f, eb = acc[ai][1][m][n] * c1 + bv[1][n] * -1.4426950408889634f;
#pragma unroll
                        for (int j = 0; j < 4; ++j) { ea[j] = fminf(ea[j], 80.f); eb[j] = fminf(eb[j], 80.f); }
                        PIN2(ea, eb);
#pragma unroll
                        for (int j = 0; j < 4; ++j) { ea[j] = __builtin_amdgcn_exp2f(ea[j]); eb[j] = __builtin_amdgcn_exp2f(eb[j]); }
                        ea += 1.0f; eb += 1.0f; PIN2(ea, eb);
                        f32x4 ra, rb;
#pragma unroll
                        for (int j = 0; j < 4; ++j) { ra[j] = __builtin_amdgcn_rcpf(ea[j]); rb[j] = __builtin_amdgcn_rcpf(eb[j]); }
                        PIN2(ra, rb);
                        rv[n] = eb * ra; sv[n] = rb; }
                    {
                        const unsigned vg = (unsigned)(((wr * 4 + wc) * 64 + fq * 16 + fr) * 16), sg = ((((unsigned)u.pm * 16u + (unsigned)(cb >> 7)) * 2u + ai) * 4u + m) * 8192u;
                        bst16(pack8(rv[0], rv[1]), ro, vg, sg); bst16(pack8(sv[0], sv[1]), ro, vg, sg + (unsigned)((size_t)M * DM * 2)); }
                    continue; }
                f32x4 c0, c1, s0, s1;
                if (rope) { c0 = __builtin_bit_cast(f32x4, bld16(rc, vc, sc + rofs * 64u)); c1 = __builtin_bit_cast(f32x4, bld16(rc, vc, sc + rofs * 64u + 16u)); s0 = __builtin_bit_cast(f32x4, bld16(rc, vc, sc + rofs * 64u + 32u)); s1 = __builtin_bit_cast(f32x4, bld16(rc, vc, sc + rofs * 64u + 48u));
                    if (fq == 0) { s0 = -s0; s1 = -s1; } }
                float z1 = 0.f, z2 = 0.f;
#pragma unroll
                for (int bj = 0; bj < 2; ++bj) { f32x4 v0 = acc[ai][bj][m][0] * rs + bv[bj][0], v1 = acc[ai][bj][m][1] * rs + bv[bj][1];
                    if (rope) { f32x4 p0, p1;
#pragma unroll
                        for (int j = 0; j < 4; ++j) { p0[j] = __shfl_xor(v0[j], 16); p1[j] = __shfl_xor(v1[j], 16); }
                        if (fq < 2) { v0 = v0 * c0 + p0 * s0; v1 = v1 * c1 + p1 * s1; } }
                    if (mode == 1) { f32x2 a = gelu_pk((f32x2){v0[0], v0[1]}), b = gelu_pk((f32x2){v0[2], v0[3]}), c = gelu_pk((f32x2){v1[0], v1[1]}), d = gelu_pk((f32x2){v1[2], v1[3]});
                        v0 = (f32x4){a.x, a.y, b.x, b.y}; v1 = (f32x4){c.x, c.y, d.x, d.y};
                        if (vstat) { z1 += (v0[0] + v0[1]) + (v0[2] + v0[3]) + (v1[0] + v1[1]) + (v1[2] + v1[3]);
                            z2 += (v0[0] * v0[0] + v0[1] * v0[1]) + (v0[2] * v0[2] + v0[3] * v0[3]) + (v1[0] * v1[0] + v1[1] * v1[1]) + (v1[2] * v1[2] + v1[3] * v1[3]); } }
                    bst16(pack8(v0, v1), ro, vo, so + (rofs * ldc + bj * HALF) * 2u); }
                if (vstat) { z1 += __shfl_xor(z1, 16); z1 += __shfl_xor(z1, 32); z2 += __shfl_xor(z2, 16); z2 += __shfl_xor(z2, 32);
                    const size_t r = (size_t)u.pm * BM + lrow + rofs;
                    if (fq == 0) { fx_add(zst + r * 2, z1, FX_ZST); fx_add(zst + r * 2 + 1, z2, FX_ZST); } } }
    }
};
struct EpiGate {
    static constexpr bool PERM = true, AFTER_DRAIN = false; static constexpr int MID_T = AW / BK; static constexpr bool BLOCKED = false;
    const bf16_t* gr; const bf16_t* gs; bf16_t* mg;
    __device__ __forceinline__ void mid(f32x4 (&acc)[2][2][4][2], const Unit& u, int wr, int wc, int fr, int fq) const {
        const rsrc_t rg = mk_rsrc(gr, (size_t)M * DM * 2);
        const unsigned vg = (unsigned)(((wr * 4 + wc) * 64 + fq * 16 + fr) * 16);
        const unsigned vo = ((wr * 64 + fr) * DM + wc * 32 + 8 * fq) * 2u, so = ((unsigned)u.pm * BM * DM + (unsigned)u.pn * BM) * 2u;
#pragma unroll
        for (int ai = 0; ai < 2; ++ai) { v4u gw[4][2];
#pragma unroll
            for (int m = 0; m < 4; ++m)
#pragma unroll
                for (int bj = 0; bj < 2; ++bj) gw[m][bj] = bld16(rg, vg, ((((unsigned)u.pm * 16u + 2u * (unsigned)u.pn + bj) * 2u + ai) * 4u + m) * 8192u);
#pragma unroll
            for (int m = 0; m < 4; ++m)
#pragma unroll
                for (int bj = 0; bj < 2; ++bj) { acc[ai][bj][m][0] *= unlo(gw[m][bj]); acc[ai][bj][m][1] *= unhi(gw[m][bj]); } }
    }
    __device__ __forceinline__ void operator()(const f32x4 (&acc)[2][2][4][2], const Unit& u, int wr, int wc, int fr, int fq) const {
        const rsrc_t rg = mk_rsrc(gs, (size_t)M * DM * 2), ro = mk_rsrc(mg, (size_t)M * DM * 2);
        const unsigned vg = (unsigned)(((wr * 4 + wc) * 64 + fq * 16 + fr) * 16);
        const unsigned vo = ((wr * 64 + fr) * DM + wc * 32 + 8 * fq) * 2u, so = ((unsigned)u.pm * BM * DM + (unsigned)u.pn * BM) * 2u;
        const unsigned vb_ = epi_img_byte(wr, wc, fr, fq) >> 1, sb_ = ((unsigned)u.pm * 2u * (DM / 64) + (unsigned)u.pn * 4u) * 8192u;
        v4u gw[2][4][2];
#pragma unroll
        for (int ai = 0; ai < 2; ++ai)
#pragma unroll
            for (int m = 0; m < 4; ++m)
#pragma unroll
                for (int bj = 0; bj < 2; ++bj) gw[ai][m][bj] = bld16(rg, vg, ((((unsigned)u.pm * 16u + 2u * (unsigned)u.pn + bj) * 2u + ai) * 4u + m) * 8192u);
#pragma unroll
        for (int ai = 0; ai < 2; ++ai)
#pragma unroll
            for (int m = 0; m < 4; ++m)
#pragma unroll
                for (int bj = 0; bj < 2; ++bj) bst16(pack8(acc[ai][bj][m][0] * unlo(gw[ai][m][bj]), acc[ai][bj][m][1] * unhi(gw[ai][m][bj])), ro, vb_ * 2u, (sb_ + ((unsigned)ai * (DM / 64) + 2u * bj) * 8192u + m * 1024u) * 2u);
    }
};
struct EpiResid {
    static constexpr bool PERM = true, AFTER_DRAIN = false; static constexpr int MID_T = 0; static constexpr bool BLOCKED = true;
    float* hout; bf16_t* hb; unsigned long long* ssq_out;
    __device__ __forceinline__ void operator()(const f32x4 (&acc)[2][2][4][2], const Unit& u, int wr, int wc, int fr, int fq) const {
        const rsrc_t rh = mk_rsrc(hout, 0), rb = mk_rsrc(hb, 0);
        const unsigned lrow = wr * 64 + fr, ve = lrow * DM + wc * 32 + 8 * fq, se = (unsigned)u.pm * BM * DM + (unsigned)u.pn * BM;
        const unsigned vb_ = epi_img_byte(wr, wc, fr, fq) >> 1, sb_ = ((unsigned)u.pm * 2u * (DM / 64) + (unsigned)u.pn * 4u) * 8192u;
        const bool out32 = hout != nullptr;
        v4u tb[2][4][2];
#pragma unroll
        for (int ai = 0; ai < 2; ++ai)
#pragma unroll
            for (int m = 0; m < 4; ++m)
#pragma unroll
                for (int bj = 0; bj < 2; ++bj) tb[ai][m][bj] = bld16(rb, vb_ * 2u, (sb_ + ((unsigned)ai * (DM / 64) + 2u * bj) * 8192u + m * 1024u) * 2u);
#pragma unroll
        for (int ai = 0; ai < 2; ++ai)
#pragma unroll
            for (int m = 0; m < 4; ++m) { float sq = 0.f;
#pragma unroll
                for (int bj = 0; bj < 2; ++bj) { const unsigned e = se + (ai * HALF + m * 16) * DM + bj * HALF, eb = sb_ + ((unsigned)ai * (DM / 64) + 2u * bj) * 8192u + m * 1024u;
                    const f32x4 v0 = acc[ai][bj][m][0] + unlo(tb[ai][m][bj]), v1 = acc[ai][bj][m][1] + unhi(tb[ai][m][bj]);
                    if (out32) { bst16(__builtin_bit_cast(v4u, v0), rh, ve * 4u, e * 4u); bst16(__builtin_bit_cast(v4u, v1), rh, ve * 4u, e * 4u + 16u); }
                    sq += (v0[0] * v0[0] + v0[1] * v0[1]) + (v0[2] * v0[2] + v0[3] * v0[3]) + (v1[0] * v1[0] + v1[1] * v1[1]) + (v1[2] * v1[2] + v1[3] * v1[3]);
                    bst16(pack8(v0, v1), rb, vb_ * 2u, eb * 2u); }
                sq += __shfl_xor(sq, 16); sq += __shfl_xor(sq, 32);
                if (fq == 0) fx_add(ssq_out + (size_t)u.pm * BM + lrow + ai * HALF + m * 16, sq, FX_SSQ); }
    }
};
struct EpiSwiglu {
    static constexpr bool PERM = true, AFTER_DRAIN = false; static constexpr int MID_T = 0; static constexpr bool BLOCKED = false;
    const unsigned long long* ssq; bf16_t* act;
    __device__ __forceinline__ void operator()(const f32x4 (&acc)[2][2][4][2], const Unit& u, int wr, int wc, int fr, int fq) const {
        const rsrc_t ro = mk_rsrc(act, (size_t)M * DFF * 2), rq = mk_rsrc(ssq, (size_t)M * 8);
        const unsigned lrow = wr * 64 + fr, vo = epi_img_byte(wr, wc, fr, fq), so = (((unsigned)u.pm * 2u * (DFF / 64) + (unsigned)u.pn * 2u) * 8192u) * 2u, vq = lrow * 8u, sq = (unsigned)u.pm * BM * 8u;
        v2u sw[2][4];
#pragma unroll
        for (int ai = 0; ai < 2; ++ai)
#pragma unroll
            for (int m = 0; m < 4; ++m) sw[ai][m] = bld8(rq, vq, sq + (ai * HALF + m * 16) * 8u);
#pragma unroll
        for (int ai = 0; ai < 2; ++ai)
#pragma unroll
            for (int m = 0; m < 4; ++m) { const float rs = rstd_from_bits(sw[ai][m]); const float c1 = rs * -1.4426950408889634f, rs2 = rs * rs;
                const f32x4 a0 = acc[ai][0][m][0], a1 = acc[ai][0][m][1];
                f32x4 e0 = a0 * c1, e1 = a1 * c1; PIN2(e0, e1);
#pragma unroll
                for (int j = 0; j < 4; ++j) { e0[j] = __builtin_amdgcn_exp2f(e0[j]); e1[j] = __builtin_amdgcn_exp2f(e1[j]); }
                f32x4 p0 = a0 * acc[ai][1][m][0], p1 = a1 * acc[ai][1][m][1]; p0 *= rs2; p1 *= rs2;
                e0 += 1.0f; e1 += 1.0f; PIN2(e0, e1);
#pragma unroll
                for (int j = 0; j < 4; ++j) { e0[j] = __builtin_amdgcn_rcpf(e0[j]); e1[j] = __builtin_amdgcn_rcpf(e1[j]); }
                PIN2(e0, e1);
                bst16nt(pack8(p0 * e0, p1 * e1), ro, vo, so + ((unsigned)ai * (DFF / 64) * 8192u + m * 16 * 64u) * 2u); }
    }
};
}

struct Frame {
    LAS unsigned char* lds; volatile LAS unsigned* MISC; gu32* ctl;
    int tid, lane, wave, vcu, G;
};
struct Args { const void* in[17]; float* out; unsigned char* ws; int ph_lo, ph_hi, li, pad; };
enum { I_X = 0, I_POS, I_N1G, I_WIN, I_BIN, I_SINKS, I_LNG, I_LNB, I_SGUW, I_SGUB, I_WAB, I_WSB, I_WOUT, I_N2G, I_WGU, I_WDN, I_FG };

constexpr int TP_PITCH = 272, TP_SCR_BYTES = 32 * TP_PITCH;
typedef short s16x4_t __attribute__((ext_vector_type(4)));
__device__ __forceinline__ void transpose_item(const float* W, int K, int N, bf16* WT, int ldk, int koff, const float* gain, int mode, LAS float* scr_, int item, int lane) {
    LAS unsigned char* scr = (LAS unsigned char*)scr_;
    const int nblk = N / 128, kb = item / nblk, nb = item % nblk, k0 = 32 * kb, n0 = 128 * nb;
    const int kr = lane >> 5, n4 = lane & 31;
    const float* src = W + (size_t)(k0 + kr) * N + n0 + 4 * n4;
    f32x4 v[16];
#pragma unroll
    for (int i = 0; i < 16; ++i) v[i] = __builtin_nontemporal_load((const f32x4*)(src + (size_t)(2 * i) * N));
    if (gain) {
#pragma unroll
        for (int i = 0; i < 16; ++i) v[i] *= gain[k0 + 2 * i + kr]; }
#pragma unroll
    for (int i = 0; i < 16; ++i) *(LAS v2u*)(scr + (2 * i + kr) * TP_PITCH + 8 * n4) = (v2u){pg8::cvtpk(v[i][0], v[i][1]), pg8::cvtpk(v[i][2], v[i][3])};
    LDS_WAIT(); asm volatile("" ::: "memory");
    int d0 = n0;
    if (mode == 1) { const int bj = n0 / DFF, rem = n0 % DFF; d0 = 256 * (rem / 128) + 128 * bj; }
    if (mode == 2 && n0 >= OFF_G) { const int rel = n0 - OFF_G, bj = rel / DM, rem = rel % DM; d0 = OFF_G + 256 * (rem / 128) + 128 * bj; }
    GAS unsigned char* dst = (GAS unsigned char*)(WT + ((size_t)(d0 >> 7) * (ldk / 64) + (koff + k0) / 64) * 8192) + (((koff + k0) >> 5) & 1) * 1024;
    const int fr = lane & 15, fq = lane >> 4, q = fr >> 2, p = fr & 3;
    const unsigned ob = (unsigned)((fr * 64 + fq * 16) ^ ((fr >> 3) << 5));
#pragma unroll
    for (int G = 0; G < 8; ++G) {
        const LAS unsigned char* tp = scr + (8 * fq + q) * TP_PITCH + (32 * (G >> 1) + 8 * p + 4 * (G & 1)) * 2;
        const s16x4_t lo = __builtin_amdgcn_ds_read_tr16_b64_v4i16((LAS s16x4_t*)tp), hi = __builtin_amdgcn_ds_read_tr16_b64_v4i16((LAS s16x4_t*)(tp + 4 * TP_PITCH));
        const v2u l2 = __builtin_bit_cast(v2u, lo), h2 = __builtin_bit_cast(v2u, hi);
        *(GAS v4u*)(dst + G * 2048 + ob) = (v4u){l2.x, l2.y, h2.x, h2.y}; }
    LDS_WAIT(); asm volatile("" ::: "memory");
}
__device__ __forceinline__ void sincos_red(float ang, float& c, float& s) {
    const double a = (double)ang; const double kq = __builtin_rint(a * 0.63661977236758134308);
    const double r = __builtin_fma(-kq, 1.57079632679489661923, a) - kq * 6.123233995736766e-17; const double r2 = r * r;
    double sp = -2.5052108385441718775e-8; sp = sp * r2 + 2.7557319223985890653e-6; sp = sp * r2 - 1.9841269841269841253e-4; sp = sp * r2 + 8.3333333333333332177e-3; sp = sp * r2 - 1.6666666666666665741e-1; sp = r + r * r2 * sp;
    double cp = 2.0876756987868098979e-9; cp = cp * r2 - 2.7557319223985890653e-7; cp = cp * r2 + 2.4801587301587301566e-5; cp = cp * r2 - 1.3888888888888889419e-3; cp = cp * r2 + 4.1666666666666664354e-2; cp = cp * r2 - 0.5; cp = 1.0 + r2 * cp;
    const int qd = ((int)(long long)kq) & 3;
    const double cs = (qd & 1) ? sp : cp, sn = (qd & 1) ? cp : sp;
    c = (float)((qd == 1 || qd == 2) ? -cs : cs); s = (float)((qd >= 2) ? -sn : sn);
}

constexpr int CI_IN = (DM / 64) * (INW / 64), CI_AB = (AW / 64) * (DM / 64), CI_SB = (SGUW / 64) * (DM / 64), CI_OUT = (DM / 64) * (DM / 64), CI_GU = (DM / 64) * (2 * DFF / 64), CI_DN = (DFF / 64) * (DM / 64);
constexpr int CI_LAYER = CI_IN + CI_AB + CI_SB + CI_OUT + CI_GU + CI_DN;
constexpr int CI_IDLE_PER_WAVE = 5;
__device__ __forceinline__ void convert_item(const Args& args, unsigned char* ws, int l, int r, LAS float* scr, int lane) {
    unsigned char* wl = ws + WS_W + (size_t)l * W_LAYER;
    const float* W; int K, N, ldk, koff = 0, mode = 0; bf16* WT; const float* gain = nullptr;
    if (r < CI_IN) { W = (const float*)args.in[I_WIN] + (size_t)l * DM * INW; K = DM; N = INW; WT = (bf16*)(wl + WL_IN); ldk = DM; gain = (const float*)args.in[I_N1G] + l * DM; mode = 2; }
    else if ((r -= CI_IN) < CI_AB) { W = (const float*)args.in[I_WAB] + (size_t)l * AW * DM; K = AW; N = DM; WT = (bf16*)(wl + WL_AB); ldk = DM; }
    else if ((r -= CI_AB) < CI_SB) { W = (const float*)args.in[I_WSB] + (size_t)l * SGUW * DM; K = SGUW; N = DM; WT = (bf16*)(wl + WL_AB); ldk = DM; koff = AW; }
    else if ((r -= CI_SB) < CI_OUT) { W = (const float*)args.in[I_WOUT] + (size_t)l * DM * DM; K = DM; N = DM; WT = (bf16*)(wl + WL_OUT); ldk = DM; }
    else if ((r -= CI_OUT) < CI_GU) { W = (const float*)args.in[I_WGU] + (size_t)l * DM * 2 * DFF; K = DM; N = 2 * DFF; WT = (bf16*)(wl + WL_GU); ldk = DM; gain = (const float*)args.in[I_N2G] + l * DM; mode = 1; }
    else { r -= CI_GU; W = (const float*)args.in[I_WDN] + (size_t)l * DFF * DM; K = DFF; N = DM; WT = (bf16*)(wl + WL_DN); ldk = DFF; }
    transpose_item(W, K, N, WT, ldk, koff, gain, mode, scr, r, lane);
}
constexpr int CS_IN = (DM / 64) * (INW / 512), CS_AB = (AW / 64) * (DM / 512), CS_SB = (SGUW / 64) * (DM / 512), CS_OUT = (DM / 64) * (DM / 512), CS_GU = (DM / 64) * (2 * DFF / 512), CS_DN = (DFF / 64) * (DM / 512);
constexpr int CS_LAYER = CS_IN + CS_AB + CS_SB + CS_OUT + CS_GU + CS_DN;
constexpr int CS_IDLE_PER_WG = 5;
constexpr int SUP_PITCH = 1088, SUP_BUF = 64 * SUP_PITCH;
static_assert(2 * SUP_BUF <= LDSCTL_OFF, "two super-item tiles must fit below the LDS control words");
static_assert(CS_LAYER * 8 == CI_LAYER, "super-items are eight items");
struct SupDesc { const float* src; const float* gain; bf16* WT; int N, ldk, koff, mode, k0, n0; };
__device__ __forceinline__ SupDesc sup_desc(const Args& args, unsigned char* ws, int l, int r) {
    unsigned char* wl = ws + WS_W + (size_t)l * W_LAYER; SupDesc d; d.gain = nullptr; d.koff = 0; d.mode = 0;
    const float* W;
    if (r < CS_IN) { W = (const float*)args.in[I_WIN] + (size_t)l * DM * INW; d.N = INW; d.WT = (bf16*)(wl + WL_IN); d.ldk = DM; d.gain = (const float*)args.in[I_N1G] + l * DM; d.mode = 2; }
    else if ((r -= CS_IN) < CS_AB) { W = (const float*)args.in[I_WAB] + (size_t)l * AW * DM; d.N = DM; d.WT = (bf16*)(wl + WL_AB); d.ldk = DM; }
    else if ((r -= CS_AB) < CS_SB) { W = (const float*)args.in[I_WSB] + (size_t)l * SGUW * DM; d.N = DM; d.WT = (bf16*)(wl + WL_AB); d.ldk = DM; d.koff = AW; }
    else if ((r -= CS_SB) < CS_OUT) { W = (const float*)args.in[I_WOUT] + (size_t)l * DM * DM; d.N = DM; d.WT = (bf16*)(wl + WL_OUT); d.ldk = DM; }
    else if ((r -= CS_OUT) < CS_GU) { W = (const float*)args.in[I_WGU] + (size_t)l * DM * 2 * DFF; d.N = 2 * DFF; d.WT = (bf16*)(wl + WL_GU); d.ldk = DM; d.gain = (const float*)args.in[I_N2G] + l * DM; d.mode = 1; }
    else { r -= CS_GU; W = (const float*)args.in[I_WDN] + (size_t)l * DFF * DM; d.N = DM; d.WT = (bf16*)(wl + WL_DN); d.ldk = DFF; }
    const int nblk = d.N / 512, kb = r / nblk, nb = r % nblk; d.k0 = 64 * kb; d.n0 = 512 * nb;
    d.src = W + (size_t)d.k0 * d.N + d.n0; if (d.gain) d.gain += d.k0;
    return d; }
__device__ __forceinline__ void sup_load(const SupDesc& d, int wave, int lane, f32x4 (&v)[16]) {
    const float* p = d.src + (size_t)(8 * wave) * d.N + 4 * lane;
#pragma unroll
    for (int j = 0; j < 8; ++j)
#pragma unroll
        for (int h = 0; h < 2; ++h) v[2 * j + h] = __builtin_nontemporal_load((const f32x4*)(p + (size_t)j * d.N + 256 * h)); }
__device__ __forceinline__ void sup_write(const SupDesc& d, int wave, int lane, const f32x4 (&v)[16], LAS unsigned char* tile) {
#pragma unroll
    for (int j = 0; j < 8; ++j) { const float g = d.gain ? d.gain[8 * wave + j] : 1.0f;
#pragma unroll
        for (int h = 0; h < 2; ++h) { const f32x4 w = v[2 * j + h] * g;
            *(LAS v2u*)(tile + (8 * wave + j) * SUP_PITCH + (256 * h + 4 * lane) * 2) = (v2u){pg8::cvtpk(w[0], w[1]), pg8::cvtpk(w[2], w[3])}; } } }
__device__ __forceinline__ void sup_out(const SupDesc& d, int wave, int lane, const LAS unsigned char* tile) {
    const int kh = wave >> 2, ns = wave & 3, n0 = d.n0 + 128 * ns;
    int d0 = n0;
    if (d.mode == 1) { const int bj = n0 / DFF, rem = n0 % DFF; d0 = 256 * (rem / 128) + 128 * bj; }
    if (d.mode == 2 && n0 >= OFF_G) { const int rel = n0 - OFF_G, bj = rel / DM, rem = rel % DM; d0 = OFF_G + 256 * (rem / 128) + 128 * bj; }
    GAS unsigned char* dst = (GAS unsigned char*)(d.WT + ((size_t)(d0 >> 7) * (d.ldk / 64) + (d.koff + d.k0) / 64) * 8192) + kh * 1024;
    const int fr = lane & 15, fq = lane >> 4, q = fr >> 2, p = fr & 3;
    const unsigned ob = (unsigned)((fr * 64 + fq * 16) ^ ((fr >> 3) << 5));
#pragma unroll
    for (int G = 0; G < 8; ++G) {
        const LAS unsigned char* tp = tile + (32 * kh + 8 * fq + q) * SUP_PITCH + (128 * ns + 32 * (G >> 1) + 8 * p + 4 * (G & 1)) * 2;
        const s16x4_t lo = __builtin_amdgcn_ds_read_tr16_b64_v4i16((LAS s16x4_t*)tp), hi = __builtin_amdgcn_ds_read_tr16_b64_v4i16((LAS s16x4_t*)(tp + 4 * SUP_PITCH));
        const v2u l2 = __builtin_bit_cast(v2u, lo), h2 = __builtin_bit_cast(v2u, hi);
        *(GAS v4u*)(dst + G * 2048 + ob) = (v4u){l2.x, l2.y, h2.x, h2.y}; } }
template <class ItemFn> __device__ __forceinline__ void sup_run(const Args& args, unsigned char* ws, int n, const ItemFn& item, LAS unsigned char* lds, int wave, int lane) {
    if (n <= 0) return;
    f32x4 v[16]; int l0, r0; item(0, l0, r0); sup_load(sup_desc(args, ws, l0, r0), wave, lane, v);
    for (int i = 0; i < n; ++i) { int l, r; item(i, l, r); const SupDesc d = sup_desc(args, ws, l, r); LAS unsigned char* tile = lds + (i & 1) * SUP_BUF;
        sup_write(d, wave, lane, v, tile);
        if (i + 1 < n) { int ln, rn; item(i + 1, ln, rn); sup_load(sup_desc(args, ws, ln, rn), wave, lane, v); }
        LDS_WAIT(); __builtin_amdgcn_s_barrier(); asm volatile("" ::: "memory");
        sup_out(d, wave, lane, tile); }
    LDS_WAIT(); __builtin_amdgcn_s_barrier(); asm volatile("" ::: "memory"); }

constexpr int NPL = 6;
constexpr int N_PHASES = 1 + DEPTH * NPL + 1;

__global__ void __launch_bounds__(NWAVES * 64, 2) fwd(Args args) {
    extern __shared__ __attribute__((aligned(16))) unsigned char lds[];
    Frame F;
    F.lds = (LAS unsigned char*)lds; F.MISC = (volatile LAS unsigned*)(F.lds + MISC_OFF);
    F.tid = threadIdx.x; F.lane = F.tid & 63; F.wave = __builtin_amdgcn_readfirstlane(F.tid >> 6);
    F.G = gridDim.x; { const int bx = blockIdx.x; F.vcu = (F.G % 8 == 0) ? (bx % 8) * (F.G / 8) + bx / 8 : bx; }
    unsigned char* ws = args.ws;
    F.ctl = (gu32*)(ws + WS_CTL);
    for (int u = F.tid; u < (LDS_BYTES - LDSCTL_OFF) / 4; u += NWAVES * 64) ((LAS unsigned*)(F.lds + LDSCTL_OFF))[u] = 0u;
    __syncthreads();
    const int lo = args.ph_lo, hi = args.ph_hi;
    const bool use_bar = (hi - lo) > 1;
    XcdBarrier bar; bar.bar = (unsigned*)(F.ctl + CW_BAR); bar.x = 0; bar.st = nullptr;
    if (use_bar) bar = xcd_barrier_post((unsigned*)(F.ctl + CW_BAR), F.MISC + 8);
#define PH_IN(id) (lo <= (id) && (id) < hi)
#define PH_END(id) do { if ((id) + 1 < hi) xcd_barrier(bar, F.wave == 0); } while (0)

    const float* x = (const float*)args.in[I_X]; const int* pos = (const int*)args.in[I_POS];
    float* h = args.out;
    bf16* hb = (bf16*)(ws + WS_HB); bf16* qb = (bf16*)(ws + WS_Q); bf16* kb = (bf16*)(ws + WS_K); bf16* vb = (bf16*)(ws + WS_V);
    bf16* zb = (bf16*)(ws + WS_Z); bf16* gb = (bf16*)(ws + WS_G); bf16* yb = (bf16*)(ws + WS_Y); bf16* mgb = (bf16*)(ws + WS_MG);
    bf16* actb = (bf16*)(ws + WS_ACT); float* tb = (float*)(ws + WS_T);
    float* cs = (float*)(ws + WS_CS); unsigned long long* ssq = (unsigned long long*)(ws + WS_SSQ); unsigned long long* zst = (unsigned long long*)(ws + WS_ZST);
    const int gw = F.vcu * NWAVES + F.wave, NGW = F.G * NWAVES, lane = F.lane;

    if (PH_IN(0)) {
        LAS float* scr = (LAS float*)(F.lds + F.wave * TP_SCR_BYTES);
        const int nwg_in = (M / 256) * (INW / 256), nrounds_in = (nwg_in + F.G - 1) / F.G, n_idle_wg = nrounds_in * F.G - nwg_in;
        const int sconv = n_idle_wg * CS_IDLE_PER_WG < CS_LAYER ? n_idle_wg * CS_IDLE_PER_WG : CS_LAYER, srem = CS_LAYER - sconv, stot = DEPTH * srem;
        { const int b = (int)blockIdx.x, G_ = F.G; const int nmine = (stot > b) ? (stot - b + G_ - 1) / G_ : 0;
          sup_run(args, ws, nmine, [=](int i, int& l, int& r) { const int it = b + i * G_; l = DEPTH - 1 - it / srem; r = srem - 1 - it % srem; }, F.lds, F.wave, lane); }
        for (int m0 = gw; m0 < M; m0 += 2 * NGW) {
            f32x4 xv[2][8];
#pragma unroll
            for (int r2 = 0; r2 < 2; ++r2) { const int m = (m0 + r2 * NGW < M) ? m0 + r2 * NGW : m0; const GAS f32x4* xr = (const GAS f32x4*)(x + (size_t)m * DM) + lane;
#pragma unroll
                for (int j = 0; j < 8; ++j) xv[r2][j] = __builtin_nontemporal_load(xr + 64 * j); }
#pragma unroll
            for (int r2 = 0; r2 < 2; ++r2) { const int m = m0 + r2 * NGW; if (m < M) {
                GAS v2u* br = (GAS v2u*)(hb + ((size_t)(m >> 7) * (DM / 64) + (lane >> 4)) * 8192 + (pg8::lds_byte(m & 127, 4 * (lane & 15)) >> 1));
                float sq = 0.f;
#pragma unroll
                for (int j = 0; j < 8; ++j) { const f32x4 v = xv[r2][j]; br[(size_t)j * 4 * 8192 / 4] = (v2u){pk2(v.x, v.y), pk2(v.z, v.w)}; sq += (v.x * v.x + v.y * v.y) + (v.z * v.z + v.w * v.w); }
                sq = wave_sum(sq); if (lane == 0) ssq[m] = fx_enc(sq, FX_SSQ); } }
        }
        for (int i = (blockIdx.x * NWAVES * 64 + F.tid); i < DEPTH * SGUG * CHUNK * CHUNK; i += F.G * NWAVES * 64) {
            const int sx = i & 127, t = (i >> 7) & 127; ((bf16*)(ws + WS_SGUWM))[i] = (sx <= t) ? (bf16)f2bf(((const float*)args.in[I_SGUW])[i]) : (bf16)0; }
        for (int i = (blockIdx.x * NWAVES * 64 + F.tid); i < M * 8; i += F.G * NWAVES * 64) {
            const int m = i >> 3, f = i & 7;
            const float invf[8] = {1.0f, 0.1939227432012558f, 0.03760603070259094f, 0.007292664609849453f, 0.0014142135623842478f, 0.00027424818836152554f, 5.318296098266728e-05f, 1.0313386155758053e-05f};
            float fr = invf[0];
#pragma unroll
            for (int q = 1; q < 8; ++q) fr = (f == q) ? invf[q] : fr;
            const float ang = (float)pos[m] * fr; float c, s; sincos_red(ang, c, s);
            cs[m * 16 + f] = c; cs[m * 16 + 8 + f] = s;
        }
        PH_END(0);
    }

    for (int l = 0; l < DEPTH; ++l) {
        const int pb = 1 + l * NPL;
        int tid_l = lane_here() + 64 * F.wave; asm volatile("" : "+v"(tid_l));
        const int lane = tid_l & 63, tidl = tid_l;
        unsigned char* wl = ws + WS_W + (size_t)l * W_LAYER;
        if (PH_IN(pb + 0)) {
            pg8::Gemm g{hb, (const bf16*)(wl + WL_IN), M, INW, DM}; pg8::StaticOrder S; S.init(M, INW, F.G, (int)blockIdx.x, 4);
            pg8::EpiInProj E{ssq + (size_t)(2 * l) * M, (const float*)args.in[I_BIN] + l * INW, cs, zst + (size_t)l * M * 2, qb, kb, vb, zb, gb};
            pg8::gemm_phase<pg8::EpiInProj, pg8::StaticOrder, true, true>(F.lds, g, S, E, F.wave);
            {
                const int nwg_in = (M / 256) * (INW / 256), nrounds_in = (nwg_in + F.G - 1) / F.G, n_idle_wg = nrounds_in * F.G - nwg_in, rank = (nrounds_in - 1) * F.G + (int)blockIdx.x - nwg_in;
                if (n_idle_wg > 0 && rank >= 0 && rank < n_idle_wg) {
                    const int sconv = n_idle_wg * CS_IDLE_PER_WG < CS_LAYER ? n_idle_wg * CS_IDLE_PER_WG : CS_LAYER; const int nmine = (sconv > rank) ? (sconv - rank + n_idle_wg - 1) / n_idle_wg : 0;
                    sup_run(args, ws, nmine, [=](int i, int& ll, int& r) { ll = l; r = CS_LAYER - sconv + rank + i * n_idle_wg; }, F.lds, F.wave, lane); } }
            PH_END(pb + 0);
        }
        if (PH_IN(pb + 1)) {
            typedef short s16x8 __attribute__((ext_vector_type(8)));
            typedef float f32x16 __attribute__((ext_vector_type(16)));
            const int q_ = lane & 31, hh = lane >> 5, wave = F.wave;
            const float* sinks = (const float*)args.in[I_SINKS] + l * NQH;
            for (int ua = F.vcu; ua < (M / 128) * NKVH; ua += F.G) {
                const int hk = ua & 3, blk = ua >> 2, nb = blk & 63, b = blk >> 6;
                const size_t row0 = (size_t)b * SEQ + (size_t)nb * 128;
                s16x8 qfa[2][4];
#pragma unroll
                for (int gi = 0; gi < 2; ++gi)
#pragma unroll
                    for (int ks = 0; ks < 4; ++ks) qfa[gi][ks] = *(const GAS s16x8*)(qb + (row0 + 32 * ((wave & 1) * 2 + gi) + q_) * AW + (hk * 4 + (wave >> 1)) * HD + 16 * ks + 8 * hh);
                LDS_WAIT(); __builtin_amdgcn_s_barrier(); asm volatile("" ::: "memory");
#pragma unroll
                for (int p = 0; p < 4; ++p) { const int chunk = p * 512 + tidl, kx = chunk >> 3, dc = chunk & 7; const bool ok = (nb > 0) || (kx >= 128);
                    v4u kv = (v4u){0u, 0u, 0u, 0u}; if (ok) kv = *(const GAS v4u*)(kb + (row0 + kx - 128) * KVW + hk * HD + dc * 8);
                    *(LAS v4u*)(F.lds + P2_K + kx * P2_KROW + dc * 16) = kv; }
#pragma unroll
                for (int p = 0; p < 4; ++p) { const int chunk = p * 512 + tidl, dc = chunk >> 8, kx = chunk & 255; const bool ok = (nb > 0) || (kx >= 128);
                    v4u vv = (v4u){0u, 0u, 0u, 0u}; if (ok) vv = *(const GAS v4u*)(vb + (row0 + kx - 128) * KVW + hk * HD + dc * 8);
                    const int pos = (kx & ~15) + 8 * ((kx >> 2) & 1) + 4 * ((kx >> 3) & 1) + (kx & 3);
                    LAS unsigned short* vp = (LAS unsigned short*)(F.lds + P2_V + (dc * 8) * P2_VROW + pos * 2);
                    vp[0 * (P2_VROW / 2)] = (unsigned short)(vv.x & 0xffffu); vp[1 * (P2_VROW / 2)] = (unsigned short)(vv.x >> 16);
                    vp[2 * (P2_VROW / 2)] = (unsigned short)(vv.y & 0xffffu); vp[3 * (P2_VROW / 2)] = (unsigned short)(vv.y >> 16);
                    vp[4 * (P2_VROW / 2)] = (unsigned short)(vv.z & 0xffffu); vp[5 * (P2_VROW / 2)] = (unsigned short)(vv.z >> 16);
                    vp[6 * (P2_VROW / 2)] = (unsigned short)(vv.w & 0xffffu); vp[7 * (P2_VROW / 2)] = (unsigned short)(vv.w >> 16); }
                LDS_WAIT(); __builtin_amdgcn_s_barrier(); asm volatile("" ::: "memory");
                const int hq = hk * 4 + (wave >> 1);
                const float sink2 = sinks[hq] * 1.4426950408889634f;
#pragma unroll
                for (int gi = 0; gi < 2; ++gi) {
                    const int tg = (wave & 1) * 2 + gi; const size_t trow = row0 + 32 * tg + q_;
                    s16x8 qf[4];
#pragma unroll
                    for (int ks = 0; ks < 4; ++ks) qf[ks] = qfa[gi][ks];
                    f32x16 st[5];
#pragma unroll
                    for (int jt = 0; jt < 5; ++jt) { const int kt = tg + jt; f32x16 a = {};
#pragma unroll
                        for (int ks = 0; ks < 4; ++ks) { const s16x8 kf = *(const LAS s16x8*)(F.lds + P2_K + (32 * kt + q_) * P2_KROW + (16 * ks + 8 * hh) * 2);
                            a = __builtin_amdgcn_mfma_f32_32x32x16_bf16(kf, qf[ks], a, 0, 0, 0); }
                        st[jt] = a; }
                    const float c2 = 0.125f * 1.4426950408889634f; const float NEGINF = -__builtin_inff();
                    float mx = sink2;
#pragma unroll
                    for (int jt = 0; jt < 5; ++jt) { const bool dead = (nb == 0) && (tg + jt < 4);
#pragma unroll
                        for (int r = 0; r < 16; ++r) { const int i = (r & 3) + 8 * (r >> 2) + 4 * hh; bool ok = !dead; if (jt == 0) ok = ok && (i > q_); if (jt == 4) ok = ok && (i <= q_);
                            const float v = ok ? st[jt][r] * c2 : NEGINF; st[jt][r] = v; mx = fmaxf(mx, v); } }
                    mx = fmaxf(mx, __shfl_xor(mx, 32));
                    float lsum = 0.f;
#pragma unroll
                    for (int jt = 0; jt < 5; ++jt)
#pragma unroll
                        for (int r = 0; r < 16; ++r) { const float pe = __builtin_amdgcn_exp2f(st[jt][r] - mx); st[jt][r] = pe; lsum += pe; }
                    lsum += __shfl_xor(lsum, 32); lsum += __builtin_amdgcn_exp2f(sink2 - mx);
                    f32x16 o0 = {}, o1 = {};
#pragma unroll
                    for (int jt = 0; jt < 5; ++jt) { const int kt = tg + jt;
#pragma unroll
                        for (int sp = 0; sp < 2; ++sp) {
                            v4u pw; pw.x = pg8::cvt_pk_bf16(st[jt][8 * sp + 0], st[jt][8 * sp + 1]); pw.y = pg8::cvt_pk_bf16(st[jt][8 * sp + 2], st[jt][8 * sp + 3]);
                            pw.z = pg8::cvt_pk_bf16(st[jt][8 * sp + 4], st[jt][8 * sp + 5]); pw.w = pg8::cvt_pk_bf16(st[jt][8 * sp + 6], st[jt][8 * sp + 7]);
                            const s16x8 pf = __builtin_bit_cast(s16x8, pw);
                            const s16x8 v0 = *(const LAS s16x8*)(F.lds + P2_V + (q_) * P2_VROW + (32 * kt + 16 * sp + 8 * hh) * 2);
                            const s16x8 v1 = *(const LAS s16x8*)(F.lds + P2_V + (32 + q_) * P2_VROW + (32 * kt + 16 * sp + 8 * hh) * 2);
                            o0 = __builtin_amdgcn_mfma_f32_32x32x16_bf16(v0, pf, o0, 0, 0, 0);
                            o1 = __builtin_amdgcn_mfma_f32_32x32x16_bf16(v1, pf, o1, 0, 0, 0); } }
                    const float inv = 1.0f / lsum;
#pragma unroll
                    for (int rq = 0; rq < 4; ++rq) {
                        *(GAS v2u*)(yb + blk_idx(trow, hq * HD + 4 * hh + 8 * rq, DM)) = (v2u){pg8::cvt_pk_bf16(o0[4 * rq + 0] * inv, o0[4 * rq + 1] * inv), pg8::cvt_pk_bf16(o0[4 * rq + 2] * inv, o0[4 * rq + 3] * inv)};
                        *(GAS v2u*)(yb + blk_idx(trow, hq * HD + 32 + 4 * hh + 8 * rq, DM)) = (v2u){pg8::cvt_pk_bf16(o1[4 * rq + 0] * inv, o1[4 * rq + 1] * inv), pg8::cvt_pk_bf16(o1[4 * rq + 2] * inv, o1[4 * rq + 3] * inv)}; }
                }
            }
            const float* lng = (const float*)args.in[I_LNG] + l * SGUW; const float* lnb = (const float*)args.in[I_LNB] + l * SGUW;
            const float* sbias = (const float*)args.in[I_SGUB] + l * SGUG * CHUNK;
            const bf16* wm_l = (const bf16*)(ws + WS_SGUWM) + (size_t)l * SGUG * CHUNK * CHUNK;
            bf16* ys = yb + AW;
            {
                constexpr int NU = (M / CHUNK) * SGUG;
                const int ct = wave & 3, tt0 = wave >> 2, tt1 = 3 - tt0;
                LAS float* lnp = (LAS float*)(F.lds + P2_LN);
                v4u zv[4], zs[4]; int gcur = -1;
                int us = F.vcu;
#define SGU_ISSUE(us_) do { const int g_ = (us_) & 7; const size_t base_ = (size_t)((us_) >> 3) * CHUNK; \
                    _Pragma("unroll") for (int p = 0; p < 4; ++p) { const int c = p * 512 + tidl, cc = c >> 7, sx = c & 127; \
                        zv[p] = *(const GAS v4u*)(zb + (base_ + sx) * (2 * SGUW) + SGUW + 128 * g_ + cc * 8); zs[p] = *(const GAS v4u*)(zst + ((size_t)l * M + base_ + sx) * 2); } } while (0)
                if (us < NU) SGU_ISSUE(us);
                for (; us < NU; us += F.G) {
                    const int g = us & 7, chunk = us >> 3; const size_t base = (size_t)chunk * CHUNK;
                    v2u uw[2][4];
#pragma unroll
                    for (int ti = 0; ti < 2; ++ti)
#pragma unroll
                        for (int rq = 0; rq < 4; ++rq) uw[ti][rq] = *(const GAS v2u*)(zb + (base + 32 * (ti == 0 ? tt0 : tt1) + q_) * (2 * SGUW) + 128 * g + 32 * ct + 4 * hh + 8 * rq);
                    LDS_WAIT(); __builtin_amdgcn_s_barrier(); asm volatile("" ::: "memory");
                    if (g != gcur) {
                        gcur = g; const bf16* wm = wm_l + (size_t)g * CHUNK * CHUNK;
                        if (tidl < 256) lnp[tidl] = (tidl < 128) ? lng[128 * g + tidl] : lnb[128 * g + tidl - 128];
#pragma unroll
                        for (int p = 0; p < 4; ++p) { const int c = p * 512 + tidl, t = c >> 4, sc = c & 15;
                            *(LAS v4u*)(F.lds + P2_WM + t * P2_SROW + sc * 16) = *(const GAS v4u*)(wm + (size_t)t * CHUNK + sc * 8); }
                        LDS_WAIT(); __builtin_amdgcn_s_barrier(); asm volatile("" ::: "memory"); }
#pragma unroll
                    for (int p = 0; p < 4; ++p) { const int c = p * 512 + tidl, cc = c >> 7, sx = c & 127;
                        const unsigned long long z0 = (unsigned long long)zs[p].x | ((unsigned long long)zs[p].y << 32), z1 = (unsigned long long)zs[p].z | ((unsigned long long)zs[p].w << 32);
                        const double zm = (double)(long long)z0 * (1.0 / (FX_ZST * SGUW)); const double zvar = (double)(long long)z1 * (1.0 / (FX_ZST * SGUW)) - zm * zm; const float mm = (float)zm, rs = 1.0f / sqrtf((float)zvar + EPS);
                        const f32x4 g0 = *(const LAS f32x4*)(lnp + cc * 8), g1 = *(const LAS f32x4*)(lnp + cc * 8 + 4), b0 = *(const LAS f32x4*)(lnp + 128 + cc * 8), b1 = *(const LAS f32x4*)(lnp + 128 + cc * 8 + 4);
                        const v4u zw = zv[p];
                        LAS unsigned short* vp = (LAS unsigned short*)(F.lds + (cc * 8) * P2_SROW + sx * 2);
                        vp[0 * (P2_SROW / 2)] = (unsigned short)f2bf((bflo(zw.x) - mm) * rs * g0[0] + b0[0]); vp[1 * (P2_SROW / 2)] = (unsigned short)f2bf((bfhi(zw.x) - mm) * rs * g0[1] + b0[1]);
                        vp[2 * (P2_SROW / 2)] = (unsigned short)f2bf((bflo(zw.y) - mm) * rs * g0[2] + b0[2]); vp[3 * (P2_SROW / 2)] = (unsigned short)f2bf((bfhi(zw.y) - mm) * rs * g0[3] + b0[3]);
                        vp[4 * (P2_SROW / 2)] = (unsigned short)f2bf((bflo(zw.z) - mm) * rs * g1[0] + b1[0]); vp[5 * (P2_SROW / 2)] = (unsigned short)f2bf((bfhi(zw.z) - mm) * rs * g1[1] + b1[1]);
                        vp[6 * (P2_SROW / 2)] = (unsigned short)f2bf((bflo(zw.w) - mm) * rs * g1[2] + b1[2]); vp[7 * (P2_SROW / 2)] = (unsigned short)f2bf((bfhi(zw.w) - mm) * rs * g1[3] + b1[3]); }
                    if (us + F.G < NU) SGU_ISSUE(us + F.G);
                    LDS_WAIT(); __builtin_amdgcn_s_barrier(); asm volatile("" ::: "memory");
                    f32x16 a0 = {}, a1 = {};
#pragma unroll
                    for (int sk = 0; sk < 8; ++sk) { const s16x8 af = *(const LAS s16x8*)(F.lds + (32 * ct + q_) * P2_SROW + (16 * sk + 8 * hh) * 2);
                        if (sk < 4) a0 = __builtin_amdgcn_mfma_f32_32x32x16_bf16(af, *(const LAS s16x8*)(F.lds + P2_WM + (32 * tt0 + q_) * P2_SROW + (16 * sk + 8 * hh) * 2), a0, 0, 0, 0);
                        a1 = __builtin_amdgcn_mfma_f32_32x32x16_bf16(af, *(const LAS s16x8*)(F.lds + P2_WM + (32 * tt1 + q_) * P2_SROW + (16 * sk + 8 * hh) * 2), a1, 0, 0, 0); }
#pragma unroll
                    for (int ti = 0; ti < 2; ++ti) { const int tt = ti == 0 ? tt0 : tt1; const f32x16 a = ti == 0 ? a0 : a1;
                        const int t = 32 * tt + q_; const size_t row = base + t; const float bs = sbias[g * CHUNK + t];
                        const int ch0 = 128 * g + 32 * ct + 4 * hh;
#pragma unroll
                        for (int rq = 0; rq < 4; ++rq) { const v2u u2 = uw[ti][rq];
                            *(GAS v2u*)(yb + blk_idx(row, AW + ch0 + 8 * rq, DM)) = (v2u){pg8::cvt_pk_bf16(bflo(u2.x) * (a[4 * rq + 0] + bs), bfhi(u2.x) * (a[4 * rq + 1] + bs)), pg8::cvt_pk_bf16(bflo(u2.y) * (a[4 * rq + 2] + bs), bfhi(u2.y) * (a[4 * rq + 3] + bs))}; } }
                }
#undef SGU_ISSUE
            }
            LDS_WAIT(); __builtin_amdgcn_s_barrier(); asm volatile("" ::: "memory");
            PH_END(pb + 1);
        }
        if (PH_IN(pb + 2)) {
            pg8::Gemm g{yb, (const bf16*)(wl + WL_AB), M, DM, DM}; pg8::StaticOrder S; S.init(M, DM, F.G, (int)blockIdx.x, 4);
            pg8::EpiGate E{gb, gb + (size_t)M * DM, mgb};
            pg8::gemm_phase<pg8::EpiGate, pg8::StaticOrder, true, true>(F.lds, g, S, E, F.wave);
            PH_END(pb + 2);
        }
        if (PH_IN(pb + 3)) {
            pg8::Gemm g{mgb, (const bf16*)(wl + WL_OUT), M, DM, DM}; pg8::StaticOrder S; S.init(M, DM, F.G, (int)blockIdx.x, 4);
            pg8::EpiResid E{nullptr, hb, ssq + (size_t)(2 * l + 1) * M};
            pg8::gemm_phase<pg8::EpiResid, pg8::StaticOrder, true, true>(F.lds, g, S, E, F.wave);
            PH_END(pb + 3);
        }
        if (PH_IN(pb + 4)) {
            pg8::Gemm g{hb, (const bf16*)(wl + WL_GU), M, 2 * DFF, DM}; pg8::StaticOrder S; S.init(M, 2 * DFF, F.G, (int)blockIdx.x, 4);
            pg8::EpiSwiglu E{ssq + (size_t)(2 * l + 1) * M, actb};
            pg8::gemm_phase<pg8::EpiSwiglu, pg8::StaticOrder, true, true>(F.lds, g, S, E, F.wave);
            PH_END(pb + 4);
        }
        if (PH_IN(pb + 5)) {
            pg8::Gemm g{actb, (const bf16*)(wl + WL_DN), M, DM, DFF}; pg8::StaticOrder S; S.init(M, DM, F.G, (int)blockIdx.x, 4);
            pg8::EpiResid E{nullptr, hb, ssq + (size_t)(2 * l + 2) * M};
            pg8::gemm_phase<pg8::EpiResid, pg8::StaticOrder, true, true>(F.lds, g, S, E, F.wave);
            PH_END(pb + 5);
        }
    }
    if (PH_IN(N_PHASES - 1)) {
        const float* fg = (const float*)args.in[I_FG];
        int lane_f = lane_here(); asm volatile("" : "+v"(lane_f));
        const int lane = lane_f;
        const int NGWF = F.G * NWAVES;
        for (int m0 = F.vcu * NWAVES + F.wave; m0 < M; m0 += 2 * NGWF) {
            v2u hw[2][8]; float rs[2];
#pragma unroll
            for (int r2 = 0; r2 < 2; ++r2) { const int m = (m0 + r2 * NGWF < M) ? m0 + r2 * NGWF : m0;
                const GAS v2u* br = (const GAS v2u*)(hb + ((size_t)(m >> 7) * (DM / 64) + (lane >> 4)) * 8192 + (pg8::lds_byte(m & 127, 4 * (lane & 15)) >> 1));
#pragma unroll
                for (int j = 0; j < 8; ++j) hw[r2][j] = br[(size_t)j * 8192];
                rs[r2] = rstd_from_ssq(ssq + (size_t)(2 * DEPTH) * M + m); }
            const GAS f32x4* gr = (const GAS f32x4*)fg + lane;
#pragma unroll
            for (int r2 = 0; r2 < 2; ++r2) { const int m = m0 + r2 * NGWF; if (m < M) { GAS f32x4* orow = (GAS f32x4*)(h + (size_t)m * DM) + lane;
#pragma unroll
                for (int j = 0; j < 8; ++j) { const v2u w = hw[r2][j]; const f32x4 v = (f32x4){bflo(w.x), bfhi(w.x), bflo(w.y), bfhi(w.y)}; orow[64 * j] = v * rs[r2] * gr[64 * j]; } } } }
    }
#undef PH_IN
#undef PH_END
}

extern "C" void kernel_launch(void* const* d_in, const int* in_sizes, int n_in, void* d_out, int out_size, void* d_ws, size_t ws_size, hipStream_t stream) {
    static int grid = 0;
    if (grid == 0) {
        if (n_in != 17 || in_sizes[0] != M * DM || out_size != M * DM || ws_size < WS_END) { fprintf(stderr, "kernel_launch: unexpected shapes (n_in %d, in0 %d, out %d, ws %zu < %zu); nothing launched\n", n_in, n_in > 0 ? in_sizes[0] : -1, out_size, ws_size, (size_t)WS_END); grid = -1; return; }
        int dev = 0, cus = 0, per_cu = 0;
        if (hipGetDevice(&dev) != hipSuccess || hipDeviceGetAttribute(&cus, hipDeviceAttributeMultiprocessorCount, dev) != hipSuccess) { grid = -1; return; }
        if (hipFuncSetAttribute((const void*)fwd, hipFuncAttributeMaxDynamicSharedMemorySize, LDS_BYTES) != hipSuccess) { fprintf(stderr, "kernel_launch: hipFuncSetAttribute failed\n"); grid = -1; return; }
        if (hipOccupancyMaxActiveBlocksPerMultiprocessor(&per_cu, (const void*)fwd, NWAVES * 64, LDS_BYTES) != hipSuccess || per_cu < 1) fprintf(stderr, "kernel_launch: occupancy query reports %d\n", per_cu);
        (void)hipGetLastError();
        grid = cus;
    }
    if (grid < 0) return;
    if (hipMemsetAsync((char*)d_ws + WS_CTL, 0, CTL_ZERO_BYTES, stream) != hipSuccess) return;
    Args a{};
    for (int i = 0; i < 17; ++i) a.in[i] = d_in[i];
    a.out = (float*)d_out; a.ws = (unsigned char*)d_ws; a.li = 0; a.pad = 0;
#if MK_ONE_LAUNCH
    a.ph_lo = 0; a.ph_hi = N_PHASES;
    hipLaunchKernelGGL(fwd, dim3(grid), dim3(NWAVES * 64), LDS_BYTES, stream, a);
#else
    for (int p = 0; p < N_PHASES; ++p) { a.ph_lo = p; a.ph_hi = p + 1; hipLaunchKernelGGL(fwd, dim3(grid), dim3(NWAVES * 64), LDS_BYTES, stream, a); }
#endif
}
```

```cpp
#include <hip/hip_runtime.h>
#include <cstdio>
#include <cstdint>
__device__ __forceinline__ int lane_here() { unsigned z = 0u; asm volatile("" : "+v"(z)); return (int)__builtin_amdgcn_mbcnt_hi(~0u, __builtin_amdgcn_mbcnt_lo(~0u, z)); }
namespace pg8 {
#define PG8_LAS __attribute__((address_space(3)))
typedef unsigned short bf16_t;
typedef short bf16x8 __attribute__((ext_vector_type(8)));
typedef float f32x4 __attribute__((ext_vector_type(4)));
typedef unsigned u32x4 __attribute__((ext_vector_type(4)));
constexpr int BM = 256, BK = 64, HALF = 128, HTB = HALF * BK * 2  , STAGE_BYTES = 8 * HTB, NXCD = 8, WGM = 8;

__host__ __device__ __forceinline__ int lds_byte(int r, int c) { const int st = (r >> 4) * 2 + (c >> 5), rr = r & 15, cc = c & 31, ob = rr * 64 + cc * 2; return st * 1024 + (ob ^ (((ob >> 9) & 1) << 5)); }
__host__ __device__ __forceinline__ void stage_rc(int b, int& R, int& C) { const int st = b / 1024, sb = b % 1024, swz = sb ^ (((sb >> 9) & 1) << 5); R = (st >> 1) * 16 + swz / 64; C = (st & 1) * 32 + (swz % 64) / 2; }
__host__ __device__ __forceinline__ int perm32(int rho) { const int n = rho >> 4, i = rho & 15; return 8 * (i >> 2) + 4 * n + (i & 3); }

struct Unit { int pm, pn; };
struct Gemm { const bf16_t* A; const bf16_t* Bt; int M, N, K; };

struct StaticOrder {
    int nM, nN, nwg, G, c, wgm;
    __host__ __device__ void init(int M, int N, int G_, int c_, int wgm_ = WGM) { nM = M / BM; nN = N / BM; nwg = nM * nN; G = G_; c = c_; wgm = wgm_; }
    __host__ __device__ bool next(int i, Unit& u) const {
        const long L = (long)i * G + c; if (L >= nwg) return false;
        int wgid = (int)L; { const int q = nwg / NXCD, r = nwg % NXCD, xcd = wgid % NXCD, off = wgid / NXCD; wgid = (xcd < r ? xcd * (q + 1) : r * (q + 1) + (xcd - r) * q) + off; }
        const int nig = wgm * nN, gid = wgid / nig, fm = gid * wgm, gsz = (nM - fm) < wgm ? (nM - fm) : wgm;
        u.pm = fm + ((wgid % nig) % gsz); u.pn = (wgid % nig) / gsz; return true;
    }
    __device__ __forceinline__ void a_ready(const Unit&) const {}
    __device__ __forceinline__ void done(const Unit&) const {}
};

__device__ __forceinline__ unsigned cvt_pk_bf16(float lo, float hi) { unsigned r; asm volatile("v_cvt_pk_bf16_f32 %0, %1, %2" : "=v"(r) : "v"(lo), "v"(hi)); return r; }
typedef float f32x2 __attribute__((ext_vector_type(2)));
__device__ __forceinline__ f32x2 gelu_pk(f32x2 v) {
    const f32x2 av = __builtin_elementwise_abs(v), d = av * 0.2316418882f + 1.0f;
    f32x2 t; t.x = __builtin_amdgcn_rcpf(d.x); t.y = __builtin_amdgcn_rcpf(d.y);
    f32x2 q = t * 0.5307027145f + (-0.7265760135f); q = q * t + 0.7107068705f; q = q * t + (-0.142248368f); q = q * t + 0.127414796f; q = q * t;
    const f32x2 s = (v * v) * (-0.72134752044f);
    f32x2 e; e.x = __builtin_amdgcn_exp2f(s.x); e.y = __builtin_amdgcn_exp2f(s.y);
    const f32x2 m = v * (q * e), r = v - m;
    f32x2 o; o.x = v.x < 0.f ? m.x : r.x; o.y = v.y < 0.f ? m.y : r.y; return o;
}

template <int ACT  > struct EpiBf16 {
    static constexpr bool PERM = true, AFTER_DRAIN = false; static constexpr int MID_T = 0; static constexpr bool BLOCKED = false; static_assert(ACT == 0 || ACT == 1, "EpiBf16: ACT is 0 (none) or 1 (gelu_pk)");
    bf16_t* O; int ldc; const float* bias; int split_cols; size_t split_stride; float scale0;
    __device__ __forceinline__ void operator()(const f32x4 (&acc)[2][2][4][2], const Unit& u, int wr, int wc, int fr, int fq) const {
        const int row0 = u.pm * BM + wr * 64 + fr; int colt = u.pn * BM; bf16_t* base = O;
        float sc = 1.f; if (split_cols) { const int t = colt / split_cols; base += (size_t)t * split_stride; colt -= t * split_cols; if (t == 0) sc = scale0; }
        const int col0 = colt + wc * 32 + 8 * fq, bcol0 = u.pn * BM + wc * 32 + 8 * fq;
        f32x4 bv[2][2];
#pragma unroll
        for (int bj = 0; bj < 2; ++bj)
#pragma unroll
            for (int n = 0; n < 2; ++n) bv[bj][n] = bias ? *(const f32x4*)(bias + bcol0 + bj * HALF + 4 * n) : (f32x4){0.f, 0.f, 0.f, 0.f};
#pragma unroll
        for (int ai = 0; ai < 2; ++ai)
#pragma unroll
            for (int m = 0; m < 4; ++m) { bf16_t* rowp = base + (size_t)(row0 + ai * HALF + m * 16) * ldc + col0;
#pragma unroll
                for (int bj = 0; bj < 2; ++bj) { f32x4 v0 = acc[ai][bj][m][0] + bv[bj][0], v1 = acc[ai][bj][m][1] + bv[bj][1];
                    if (ACT == 1) { f32x2 a = gelu_pk((f32x2){v0[0], v0[1]}), b = gelu_pk((f32x2){v0[2], v0[3]}), c = gelu_pk((f32x2){v1[0], v1[1]}), d = gelu_pk((f32x2){v1[2], v1[3]});
                        v0 = (f32x4){a.x, a.y, b.x, b.y}; v1 = (f32x4){c.x, c.y, d.x, d.y}; }
                    v0 = v0 * sc; v1 = v1 * sc; u32x4 w; w.x = cvt_pk_bf16(v0[0], v0[1]); w.y = cvt_pk_bf16(v0[2], v0[3]); w.z = cvt_pk_bf16(v1[0], v1[1]); w.w = cvt_pk_bf16(v1[2], v1[3]);
                    *(u32x4*)(rowp + bj * HALF) = w; } }
    }
};


template <class Epi, class Sched, bool ALIGN_EPI = false, bool SP2 = false>
__device__ __forceinline__ void gemm_phase(PG8_LAS unsigned char* lds, const Gemm g, const Sched& S, const Epi& E, const int wave_id) {
    int tid_ = lane_here() + 64 * wave_id; asm volatile("" : "+v"(tid_));
    const int tid = tid_, wid = __builtin_amdgcn_readfirstlane(tid >> 6), lane = tid & 63, wr = wid >> 2, wc = wid & 3, fr = lane & 15, fq = lane >> 4;
    const int K = g.K, nt = K / BK;
    unsigned voffA[2], voffB[2];
#pragma unroll
    for (int i = 0; i < 2; ++i) { int R, C; stage_rc(tid * 16 + i * 8192, R, C); const int Rb = Epi::PERM ? ((R & ~31) + perm32(R & 31)) : R;
        (void)R; (void)C; (void)Rb; voffA[i] = (unsigned)(tid * 16 + i * 8192); voffB[i] = voffA[i]; }
    const unsigned kstep = (unsigned)(HALF * BK * 2);
    const unsigned hstep = (unsigned)HALF * (unsigned)K * 2u;
    const unsigned tstep = 2u * hstep;
    const unsigned ldsw = (unsigned)wid * 1024u;
    const int aoff = lds_byte(wr * 64 + fr, fq * 8), boff = lds_byte(wc * 32 + fr, fq * 8);
#define PG8_SA(b, h) (((b) * 2 + (h)) * HTB)
#define PG8_SB(b, h) ((4 + (b) * 2 + (h)) * HTB)
    const __amdgpu_buffer_rsrc_t srdA = __builtin_amdgcn_make_buffer_rsrc((void*)g.A, (short)0, (int)((size_t)g.M * (size_t)K * 2), 0x00020000);
    const __amdgpu_buffer_rsrc_t srdB = __builtin_amdgcn_make_buffer_rsrc((void*)g.Bt, (short)0, (int)((size_t)g.N * (size_t)K * 2), 0x00020000);
    const unsigned ldsb = __builtin_amdgcn_readfirstlane((unsigned)(__UINTPTR_TYPE__)lds);
#define PG8_STAGEX(srd, bufoff, off32, voff) do { _Pragma("unroll") for (int _i = 0; _i < 2; ++_i) { const unsigned m0_ = ldsb + (unsigned)(bufoff) + ldsw + (unsigned)(_i * 8192); const unsigned so_ = (unsigned)(off32); \
        asm volatile("s_mov_b32 m0, %0\n\ts_nop 0\n\tbuffer_load_dwordx4 %1, %2, %3 offen lds" :: "s"(m0_), "v"((voff)[_i]), "s"(srd), "s"(so_) : "m0", "memory"); } } while (0)
#define PG8_STAGEA(bufoff, off32, voff) PG8_STAGEX(srdA, bufoff, off32, voff)
#define PG8_STAGEB(bufoff, off32, voff) PG8_STAGEX(srdB, bufoff, off32, voff)
#define PG8_LDA(dst, b, h) do { _Pragma("unroll") for (int m = 0; m < 4; ++m) _Pragma("unroll") for (int k = 0; k < 2; ++k) dst[m][k] = *(const PG8_LAS bf16x8*)(lds + PG8_SA(b, h) + aoff + m * 2048 + k * 1024); } while (0)
#define PG8_LDB(dst, b, h) do { _Pragma("unroll") for (int n = 0; n < 2; ++n) _Pragma("unroll") for (int k = 0; k < 2; ++k) dst[n][k] = *(const PG8_LAS bf16x8*)(lds + PG8_SB(b, h) + boff + n * 2048 + k * 1024); } while (0)
#define PG8_MMA(ai, bj, At, Bt) do { __builtin_amdgcn_s_setprio(1); _Pragma("unroll") for (int m = 0; m < 4; ++m) _Pragma("unroll") for (int n = 0; n < 2; ++n) _Pragma("unroll") for (int k = 0; k < 2; ++k) \
        acc[ai][bj][m][n] = __builtin_amdgcn_mfma_f32_16x16x32_bf16(Bt[n][k], At[m][k], acc[ai][bj][m][n], 0, 0, 0); __builtin_amdgcn_s_setprio(0); } while (0)
#define PG8_WAIT_V(n) asm volatile("s_waitcnt vmcnt(" #n ")" ::: "memory")
#define PG8_WAIT_L(n) asm volatile("s_waitcnt lgkmcnt(" #n ")" ::: "memory")
#define PG8_BAR __builtin_amdgcn_s_barrier()
#define PG8_SCHED __builtin_amdgcn_sched_barrier(0)
    Unit cur, nxt; int ui = 0;
    if (!S.next(0, cur)) return;
    f32x4 acc[2][2][4][2];
#pragma unroll
    for (int a = 0; a < 2; ++a)
#pragma unroll
        for (int b = 0; b < 2; ++b)
#pragma unroll
            for (int m = 0; m < 4; ++m)
#pragma unroll
                for (int n = 0; n < 2; ++n) acc[a][b][m][n] = (f32x4){0.f, 0.f, 0.f, 0.f};
    bf16x8 At[4][2], B0[2][2], B1[2][2];
    unsigned cA = (unsigned)cur.pm * tstep, cB = (unsigned)cur.pn * tstep;
    S.a_ready(cur);
    if constexpr (SP2) {
        PG8_STAGEB(PG8_SB(0, 0), cB, voffB); PG8_STAGEB(PG8_SB(0, 1), cB + hstep, voffB); PG8_STAGEA(PG8_SA(0, 0), cA, voffA); PG8_STAGEA(PG8_SA(0, 1), cA + hstep, voffA);
        if (wr == 1) PG8_BAR;
        PG8_WAIT_V(2); PG8_BAR;
        PG8_STAGEB(PG8_SB(1, 0), cB + kstep, voffB); PG8_STAGEA(PG8_SA(1, 0), cA + kstep, voffA); PG8_STAGEB(PG8_SB(1, 1), cB + hstep + kstep, voffB);
        PG8_WAIT_V(6); PG8_BAR;
    } else {
        PG8_STAGEB(PG8_SB(0, 0), cB, voffB); PG8_STAGEA(PG8_SA(0, 0), cA, voffA); PG8_STAGEB(PG8_SB(0, 1), cB + hstep, voffB); PG8_STAGEA(PG8_SA(0, 1), cA + hstep, voffA);
        if (wr == 1) PG8_BAR;
        PG8_WAIT_V(4); PG8_BAR;
        PG8_STAGEB(PG8_SB(1, 0), cB + kstep, voffB); PG8_STAGEA(PG8_SA(1, 0), cA + kstep, voffA); PG8_STAGEB(PG8_SB(1, 1), cB + hstep + kstep, voffB);
        PG8_WAIT_V(6); PG8_BAR;
    }
    for (;;) {
        const bool has_next = S.next(ui + 1, nxt);
        const unsigned nA = has_next ? (unsigned)nxt.pm * tstep : cA, nB = has_next ? (unsigned)nxt.pn * tstep : cB;
        for (int t = 0; t < nt; t += 2) {
            if constexpr (Epi::MID_T > 0) { if (t == Epi::MID_T) E.mid(acc, cur, wr, wc, fr, fq); }
            const bool last = (t == nt - 2);
            const unsigned a1 = cA + (unsigned)(t + 1) * kstep;
            const unsigned a2 = last ? nA : cA + (unsigned)(t + 2) * kstep, b2 = last ? nB : cB + (unsigned)(t + 2) * kstep;
            const unsigned a3 = a2 + kstep, b3 = b2 + kstep;
            if (last && has_next) S.a_ready(nxt);
            if constexpr (SP2) {
            PG8_LDB(B0, 0, 0); PG8_LDB(B1, 0, 1); PG8_SCHED; PG8_LDA(At, 0, 0); PG8_STAGEA(PG8_SA(1, 1), a1 + hstep, voffA);
            PG8_WAIT_V(8); PG8_WAIT_L(0); PG8_BAR; PG8_MMA(0, 0, At, B0); PG8_MMA(0, 1, At, B1); PG8_BAR; PG8_SCHED;
            PG8_LDA(At, 0, 1); PG8_STAGEB(PG8_SB(0, 0), b2, voffB); PG8_STAGEB(PG8_SB(0, 1), b2 + hstep, voffB); PG8_STAGEA(PG8_SA(0, 0), a2, voffA);
            PG8_WAIT_V(8); PG8_WAIT_L(0); PG8_BAR; PG8_MMA(1, 0, At, B0); PG8_MMA(1, 1, At, B1); PG8_BAR; PG8_SCHED;
            PG8_LDB(B0, 1, 0); PG8_LDB(B1, 1, 1); PG8_SCHED; PG8_LDA(At, 1, 0); PG8_STAGEA(PG8_SA(0, 1), a2 + hstep, voffA);
            PG8_WAIT_V(8); PG8_WAIT_L(0); PG8_BAR; PG8_MMA(0, 0, At, B0); PG8_MMA(0, 1, At, B1); PG8_BAR; PG8_SCHED;
            PG8_LDA(At, 1, 1); PG8_STAGEB(PG8_SB(1, 0), b3, voffB); PG8_STAGEB(PG8_SB(1, 1), b3 + hstep, voffB); PG8_STAGEA(PG8_SA(1, 0), a3, voffA);
            PG8_WAIT_V(8); PG8_WAIT_L(0); PG8_BAR; PG8_MMA(1, 0, At, B0); PG8_MMA(1, 1, At, B1); PG8_BAR; PG8_SCHED;
            } else {
            PG8_LDB(B0, 0, 0); PG8_SCHED; PG8_LDA(At, 0, 0); PG8_STAGEA(PG8_SA(1, 1), a1 + hstep, voffA);
            PG8_WAIT_L(8); PG8_BAR; PG8_WAIT_L(0); PG8_MMA(0, 0, At, B0); PG8_BAR; PG8_SCHED;
            PG8_LDB(B1, 0, 1); PG8_STAGEB(PG8_SB(0, 0), b2, voffB);
            PG8_BAR; PG8_WAIT_L(0); PG8_MMA(0, 1, At, B1); PG8_BAR;
            PG8_LDA(At, 0, 1); PG8_STAGEA(PG8_SA(0, 0), a2, voffA);
            PG8_BAR; PG8_WAIT_L(0); PG8_MMA(1, 0, At, B0); PG8_BAR; PG8_SCHED;
            PG8_STAGEB(PG8_SB(0, 1), b2 + hstep, voffB);
            PG8_WAIT_V(6); PG8_BAR; PG8_MMA(1, 1, At, B1); PG8_BAR;
            PG8_LDB(B0, 1, 0); PG8_SCHED; PG8_LDA(At, 1, 0); PG8_STAGEA(PG8_SA(0, 1), a2 + hstep, voffA);
            PG8_WAIT_L(8); PG8_BAR; PG8_WAIT_L(0); PG8_MMA(0, 0, At, B0); PG8_BAR; PG8_SCHED;
            PG8_LDB(B1, 1, 1); PG8_STAGEB(PG8_SB(1, 0), b3, voffB);
            PG8_BAR; PG8_WAIT_L(0); PG8_MMA(0, 1, At, B1); PG8_BAR;
            PG8_LDA(At, 1, 1); PG8_STAGEA(PG8_SA(1, 0), a3, voffA);
            PG8_BAR; PG8_WAIT_L(0); PG8_MMA(1, 0, At, B0); PG8_BAR; PG8_SCHED;
            PG8_STAGEB(PG8_SB(1, 1), b3 + hstep, voffB);
            PG8_WAIT_V(6); PG8_BAR; PG8_MMA(1, 1, At, B1); PG8_BAR;
            }
        }
        if constexpr (ALIGN_EPI) { if (wr == 0) PG8_BAR; }
        if constexpr (!Epi::AFTER_DRAIN) { E(acc, cur, wr, wc, fr, fq); S.done(cur); }
        if (!has_next) break;
#pragma unroll
        for (int a = 0; a < 2; ++a)
#pragma unroll
            for (int b = 0; b < 2; ++b)
#pragma unroll
                for (int m = 0; m < 4; ++m)
#pragma unroll
                    for (int n = 0; n < 2; ++n) acc[a][b][m][n] = (f32x4){0.f, 0.f, 0.f, 0.f};
        cur = nxt; cA = nA; cB = nB; ++ui;
        if constexpr (ALIGN_EPI) { if (wr == 1) PG8_BAR; }
    }
    PG8_WAIT_V(0);
    if constexpr (!ALIGN_EPI) { if (wr == 0) PG8_BAR; }
    PG8_BAR;
    if constexpr (Epi::AFTER_DRAIN) { E.fused(acc, cur, wr, wc, fr, fq, lds, wid, lane); S.done(cur); }
#undef PG8_SA
#undef PG8_SB
#undef PG8_STAGEX
#undef PG8_STAGEA
#undef PG8_STAGEB
#undef PG8_LDA
#undef PG8_LDB
#undef PG8_MMA
#undef PG8_WAIT_V
#undef PG8_WAIT_L
#undef PG8_BAR
#undef PG8_SCHED
}
}

#define GAS __attribute__((address_space(1)))
#define LAS __attribute__((address_space(3)))
typedef unsigned short bf16;
typedef unsigned v4u __attribute__((ext_vector_type(4)));
typedef float f32x4 __attribute__((ext_vector_type(4)));
typedef short bf16x8 __attribute__((ext_vector_type(8)));
typedef GAS unsigned gu32;
typedef GAS unsigned long long gu64;
#define RLX_AGENT __ATOMIC_RELAXED, __HIP_MEMORY_SCOPE_AGENT
#define LDS_WAIT() asm volatile("s_waitcnt lgkmcnt(0)" ::: "memory")
#define VM_WAIT() asm volatile("s_waitcnt vmcnt(0)" ::: "memory")
__device__ __forceinline__ unsigned long long rt() { return __builtin_amdgcn_s_memrealtime(); }
__device__ __forceinline__ unsigned f2bf(float f) { unsigned u = __builtin_bit_cast(unsigned, f); return (u + 0x7fffu + ((u >> 16) & 1u)) >> 16; }
__device__ __forceinline__ unsigned pk2(float lo, float hi) { return f2bf(lo) | (f2bf(hi) << 16); }

#define XB_TMO      128
#define XB_XCNT(j)  (256  + 64 * (j))
#define XB_XSUB(j)  (1280 + 64 * (j))
#define XB_XGEN(j)  (2304 + 64 * (j))
#define XB_TOP      3328
#define XB_TOPGEN   3392
#define XCD_BAR_WORDS 3456
#define XB_SPIN_CAP (1u << 18)

__device__ __forceinline__ unsigned xb_ld(unsigned* p)              { return __hip_atomic_load(p, __ATOMIC_RELAXED, __HIP_MEMORY_SCOPE_AGENT); }
__device__ __forceinline__ unsigned xb_add(unsigned* p, unsigned v) { return __hip_atomic_fetch_add(p, v, __ATOMIC_RELAXED, __HIP_MEMORY_SCOPE_AGENT); }
__device__ __forceinline__ unsigned xb_xcc_id() { return (unsigned)__builtin_amdgcn_s_getreg((3 << 11) | 20) & 0xFu; }
#define XB_SPIN(cond, bar) do { unsigned _sp = 0; while (cond) { __builtin_amdgcn_s_sleep(1); \
    if ((++_sp & 255u) == 0u) { if (xb_ld(&(bar)[XB_TMO])) break; if (_sp > XB_SPIN_CAP) { atomicAdd(&(bar)[XB_TMO], 1u); break; } } } } while (0)

struct XcdBarrier {
    unsigned* bar; unsigned x;
    volatile LAS unsigned* st;
};

__device__ __forceinline__ XcdBarrier xcd_barrier_post(unsigned* bar, volatile LAS unsigned* st) {
    XcdBarrier b; b.bar = bar; b.x = xb_xcc_id(); b.st = st;
    if (threadIdx.x == 0) (void)xb_add(&bar[XB_XCNT(b.x)], 1u);
    return b;
}
__device__ __forceinline__ void xcd_barrier_complete(unsigned* bar, unsigned x, unsigned& nloc, unsigned& nx) {
    const unsigned G = gridDim.x * gridDim.y * gridDim.z;
    unsigned sum, cnt, mine, sp = 0u;
    for (;;) {
        sum = 0u; cnt = 0u; mine = 0u;
#pragma unroll
        for (unsigned j = 0; j < 16; ++j) { const unsigned c = xb_ld(&bar[XB_XCNT(j)]); sum += c; cnt += (c > 0u) ? 1u : 0u; mine = (j == x) ? c : mine; }
        if (sum == G) break;
        __builtin_amdgcn_s_sleep(1);
        if ((++sp & 255u) == 0u) { if (xb_ld(&bar[XB_TMO])) break; if (sp > XB_SPIN_CAP) { atomicAdd(&bar[XB_TMO], 1u); break; } }
    }
    nloc = mine > 0u ? mine : 1u; nx = cnt > 0u ? cnt : 1u;
}

__device__ __forceinline__ void xcd_barrier(const XcdBarrier& b, const bool xb_wave0, const bool rel = true) {
    asm volatile("s_waitcnt vmcnt(0)" ::: "memory");
    __syncthreads();
    if (xb_wave0 && lane_here() == 0) {
        unsigned* bar = b.bar;
        __builtin_amdgcn_s_waitcnt(0);
        unsigned nloc = b.st[0], nx = b.st[1];
        if (nloc == 0u) { xcd_barrier_complete(bar, b.x, nloc, nx); b.st[0] = nloc; b.st[1] = nx; }
        const unsigned old = xb_add(&bar[XB_XSUB(b.x)], 1u);
        const unsigned gen = old / nloc;
        if (old + 1u == (gen + 1u) * nloc) {
            if (rel) __builtin_amdgcn_fence(__ATOMIC_RELEASE, "agent");
            asm volatile("s_waitcnt vmcnt(0)" ::: "memory");
            const unsigned og = xb_add(&bar[XB_TOP], 1u);
            const unsigned tg = og / nx;
            if (og + 1u == (tg + 1u) * nx) xb_add(&bar[XB_TOPGEN], 1u);
            else XB_SPIN(xb_ld(&bar[XB_TOPGEN]) == tg, bar);
            __builtin_amdgcn_fence(__ATOMIC_ACQUIRE, "agent");
            xb_add(&bar[XB_XGEN(b.x)], 1u);
            asm volatile("s_waitcnt vmcnt(0)" ::: "memory");
        } else {
            XB_SPIN(xb_ld(&bar[XB_XGEN(b.x)]) == gen, bar);
            __builtin_amdgcn_fence(__ATOMIC_ACQUIRE, "agent");
            asm volatile("s_waitcnt vmcnt(0)" ::: "memory");
        }
    }
    __syncthreads();
}


__device__ __forceinline__ void xcc_local_barrier(unsigned* ctr, volatile LAS unsigned* st, const unsigned nwg_cls, const bool xb_wave0) {
    asm volatile("s_waitcnt vmcnt(0)" ::: "memory");
    __syncthreads();
    if (xb_wave0 && lane_here() == 0) {
        const unsigned k = st[0] + 1u;
        (void)xb_add(ctr, 1u);
        { unsigned sp = 0u; while (xb_ld(ctr) < k * nwg_cls) { __builtin_amdgcn_s_sleep(1); if (++sp > (1u << 22)) break; } }
        __builtin_amdgcn_fence(__ATOMIC_ACQUIRE, "agent");
        asm volatile("s_waitcnt vmcnt(0)" ::: "memory");
        st[0] = k;
    }
    __syncthreads();
}

constexpr int NWAVES = 8;
#ifndef MK_ONE_LAUNCH
#define MK_ONE_LAUNCH 1
#endif
constexpr int BATCH = 2, SEQ = 8192, M = BATCH * SEQ, DM = 2048, DEPTH = 4;
constexpr int NQH = 16, NKVH = 4, HD = 64, AW = 1024, KVW = 256, WIN = 128;
constexpr int SGUW = 1024, SGUG = 8, CHUNK = 128, DFF = 5632;
constexpr int OFF_Q = 0, OFF_K = 1024, OFF_V = 1280, OFF_Z = 1536, OFF_G = 3584, INW = 7680;
constexpr float EPS = 1e-5f;

constexpr size_t MiB = 1u << 20;
constexpr size_t WS_CTL = 0, CTL_ZERO_BYTES = 4 * MiB;
constexpr size_t WS_SSQ = 1 * MiB;
constexpr size_t WS_ZST = 2 * MiB + 512 * 1024;
constexpr size_t WS_CS = 4 * MiB;
constexpr size_t WS_W = 8 * MiB, W_LAYER = 112 * MiB;
constexpr size_t WL_IN = 0, WL_AB = 30 * MiB, WL_SB = 34 * MiB, WL_OUT = 38 * MiB, WL_GU = 46 * MiB, WL_DN = 90 * MiB;
constexpr size_t WS_HB = WS_W + DEPTH * W_LAYER;
constexpr size_t WS_Q = WS_HB + 64 * MiB, WS_K = WS_Q + 32 * MiB, WS_V = WS_K + 8 * MiB;
constexpr size_t WS_Z = WS_V + 8 * MiB;
constexpr size_t WS_G = WS_Z + 64 * MiB;
constexpr size_t WS_Y = WS_G + 128 * MiB;
constexpr size_t WS_MG = WS_Y + 64 * MiB;
constexpr size_t WS_ACT = WS_MG + 64 * MiB;
constexpr size_t WS_T = WS_ACT;
constexpr size_t WS_END = WS_ACT + 176 * MiB;
static_assert((size_t)INW * DM * 2 <= 30 * MiB && (size_t)2 * DM * DFF * 2 <= 44 * MiB && (size_t)DM * DFF * 2 <= 22 * MiB, "weight map");
static_assert((size_t)M * DFF * 2 <= 176 * MiB && (size_t)M * DM * 4 <= 176 * MiB, "act map");
constexpr int CW_BAR = 4096, CW_XTAB = 16384, CW_XL = 20480;
constexpr size_t WS_SGUWM = 5 * MiB;
constexpr int P2_KROW = 144, P2_VROW = 528, P2_SROW = 272, P2_K = 0, P2_V = 256 * P2_KROW, P2_LN = 72 * 1024, P2_WM = 76 * 1024;

constexpr int RING_BYTES = 131072, LDS_BYTES = 147456, LDSCTL_OFF = LDS_BYTES - 1024, MISC_OFF = LDSCTL_OFF + 320;

typedef unsigned v2u __attribute__((ext_vector_type(2)));
typedef float f32x2 __attribute__((ext_vector_type(2)));
__device__ __forceinline__ float bf2f(unsigned h) { return __builtin_bit_cast(float, h << 16); }
__device__ __forceinline__ float bflo(unsigned w) { return __builtin_bit_cast(float, w << 16); }
__device__ __forceinline__ float bfhi(unsigned w) { return __builtin_bit_cast(float, w & 0xffff0000u); }
__device__ __forceinline__ float wave_sum(float v) {
#pragma unroll
    for (int o = 1; o < 64; o <<= 1) v += __shfl_xor(v, o);
    return v;
}
__device__ __forceinline__ float wave_max(float v) {
#pragma unroll
    for (int o = 1; o < 64; o <<= 1) v = fmaxf(v, __shfl_xor(v, o));
    return v;
}
constexpr double FX_SSQ = 1048576.0, FX_ZST = 4294967296.0;
__device__ __forceinline__ unsigned long long fx_enc(float v, double scale) { return (unsigned long long)(long long)((double)v * scale); }
__device__ __forceinline__ void fx_add(unsigned long long* p, float v, double scale) { __hip_atomic_fetch_add(p, fx_enc(v, scale), __ATOMIC_RELAXED, __HIP_MEMORY_SCOPE_AGENT); }
__device__ __forceinline__ float rstd_from_ssq(const unsigned long long* p) { const unsigned long long v = *p; const float f = (float)(unsigned)(v >> 32) * 4294967296.0f + (float)(unsigned)v;
    return __builtin_amdgcn_rsqf(f * (float)(1.0 / (FX_SSQ * 2048.0)) + 1e-5f); }
__device__ __forceinline__ float sigmoidf_(float x) { return __builtin_amdgcn_rcpf(1.0f + __builtin_amdgcn_exp2f(-1.4426950408889634f * x)); }

__device__ __forceinline__ size_t blk_idx(size_t r, int c, int cols) { return ((r >> 7) * (size_t)(cols >> 6) + (size_t)(c >> 6)) * 8192 + (size_t)(pg8::lds_byte((int)(r & 127), c & 63) >> 1); }
__device__ __forceinline__ unsigned epi_img_byte(int wr, int wc, int fr, int fq) { return (unsigned)((wc >> 1) * 16384 + (8 * wr + (wc & 1)) * 1024 + ((fr * 64 + 16 * fq) ^ ((fr >> 3) << 5))); }
struct rsrc_t { const char* p; };
__device__ __forceinline__ rsrc_t mk_rsrc(const void* p, size_t) { rsrc_t r; r.p = (const char*)p; return r; }
__device__ __forceinline__ v4u bld16(rsrc_t r, unsigned voff, unsigned soff) { const char* sb = r.p + soff; asm volatile("" : "+s"(sb)); return *(const GAS v4u*)((const GAS char*)sb + voff); }
__device__ __forceinline__ v2u bld8(rsrc_t r, unsigned voff, unsigned soff) { const char* sb = r.p + soff; asm volatile("" : "+s"(sb)); return *(const GAS v2u*)((const GAS char*)sb + voff); }
__device__ __forceinline__ void bst16nt(v4u v, rsrc_t r, unsigned voff, unsigned soff) { const char* sb = r.p + soff; asm volatile("" : "+s"(sb)); __builtin_nontemporal_store(v, (GAS v4u*)((GAS char*)sb + voff)); }
__device__ __forceinline__ void bst16(v4u v, rsrc_t r, unsigned voff, unsigned soff) { const char* sb = r.p + soff; asm volatile("" : "+s"(sb)); *(GAS v4u*)((GAS char*)sb + voff) = v; }
__device__ __forceinline__ float rstd_from_bits(v2u w) { const float f = (float)w.y * 4294967296.0f + (float)w.x; return __builtin_amdgcn_rsqf(f * (float)(1.0 / (FX_SSQ * 2048.0)) + 1e-5f); }
namespace pg8 {
typedef __bf16 bf16x2_t __attribute__((ext_vector_type(2)));
__device__ __forceinline__ unsigned cvtpk(float lo, float hi) { const f32x2 v = {lo, hi}; return __builtin_bit_cast(unsigned, __builtin_convertvector(v, bf16x2_t)); }
__device__ __forceinline__ v4u pack8(const f32x4 v0, const f32x4 v1) { v4u w; w.x = cvtpk(v0[0], v0[1]); w.y = cvtpk(v0[2], v0[3]); w.z = cvtpk(v1[0], v1[1]); w.w = cvtpk(v1[2], v1[3]); return w; }
#define PIN2(a, b) asm volatile("" : "+v"(a), "+v"(b))
__device__ __forceinline__ f32x4 unlo(const v4u w) { return (f32x4){bflo(w.x), bfhi(w.x), bflo(w.y), bfhi(w.y)}; }
__device__ __forceinline__ f32x4 unhi(const v4u w) { return (f32x4){bflo(w.z), bfhi(w.z), bflo(w.w), bfhi(w.w)}; }
struct EpiInProj {
    static constexpr bool PERM = true, AFTER_DRAIN = false; static constexpr int MID_T = 0; static constexpr bool BLOCKED = false;
    const unsigned long long* ssq; const float* bias; const float* cs; unsigned long long* zst; bf16_t *q, *k, *v, *z, *g;
    __device__ __forceinline__ void operator()(const f32x4 (&acc)[2][2][4][2], const Unit& u, int wr, int wc, int fr, int fq) const {
        const int colt = u.pn * BM;
        bf16_t* base; int ldc, cb, mode;
        if (colt < OFF_K) { base = q; ldc = AW; cb = colt; mode = 0; }
        else if (colt < OFF_V) { base = k; ldc = KVW; cb = colt - OFF_K; mode = 0; }
        else if (colt < OFF_Z) { base = v; ldc = KVW; cb = colt - OFF_V; mode = 0; }
        else if (colt < OFF_G) { base = z; ldc = 2 * SGUW; cb = colt - OFF_Z; mode = 1; }
        else { base = g; ldc = DM; cb = (colt - OFF_G) >> 1; mode = 2; }
        const bool rope = (colt < OFF_V) && ((wc & 1) == 0);
        const bool vstat = (mode == 1) && (cb >= SGUW);
        const rsrc_t ro = mk_rsrc(base, (size_t)M * ldc * (mode == 2 ? 4 : 2)), rq = mk_rsrc(ssq, (size_t)M * 8), rc = mk_rsrc(cs, (size_t)M * 64);
        const unsigned lrow = wr * 64 + fr, vo = (lrow * ldc + wc * 32 + 8 * fq) * 2u, vq = lrow * 8u, vc = lrow * 64u;
        const unsigned so = ((unsigned)u.pm * BM * ldc + cb) * 2u, sq = (unsigned)u.pm * BM * 8u, sc = (unsigned)u.pm * BM * 64u;
        const int bcol0 = (mode == 2 ? OFF_G + cb : colt) + wc * 32 + 8 * fq;
        f32x4 bv[2][2];
#pragma unroll
        for (int bj = 0; bj < 2; ++bj)
#pragma unroll
            for (int n = 0; n < 2; ++n) bv[bj][n] = *(const f32x4*)(bias + bcol0 + bj * (mode == 2 ? DM : HALF) + 4 * n);
        v2u sw[2][4];
#pragma unroll
        for (int ai = 0; ai < 2; ++ai)
#pragma unroll
            for (int m = 0; m < 4; ++m) sw[ai][m] = bld8(rq, vq, sq + (ai * HALF + m * 16) * 8u);
#pragma unroll
        for (int ai = 0; ai < 2; ++ai)
#pragma unroll
            for (int m = 0; m < 4; ++m) { const unsigned rofs = (ai * HALF + m * 16); const float rs = rstd_from_bits(sw[ai][m]);
                if (mode == 2) {
                    const float c1 = rs * -1.4426950408889634f; f32x4 rv[2], sv[2];
#pragma unroll
                    for (int n = 0; n < 2; ++n) {
                        f32x4 ea = acc[ai][0][m][n] * c1 + bv[0][n] * -1.4426950408889634f, eb = acc[ai][1][m][n] * c1 + bv[1][n] * -1.4426950408889634f;
#pragma unroll
                        for (int j = 0; j < 4; ++j) { ea[j] = fminf(ea[j], 80.f); eb[j] = fminf(eb[j], 80.f); }
                        PIN2(ea, eb);
#pragma unroll
                        for (int j = 0; j < 4; ++j) { ea[j] = __builtin_amdgcn_exp2f(ea[j]); eb[j] = __builtin_amdgcn_exp2f(eb[j]); }
                        ea += 1.0f; eb += 1.0f; PIN2(ea, eb);
                        f32x4 ra, rb;
#pragma unroll
                        for (int j = 0; j < 4; ++j) { ra[j] = __builtin_amdgcn_rcpf(ea[j]); rb[j] = __builtin_amdgcn_rcpf(eb[j]); }
                        PIN2(ra, rb);
                        rv[n] = eb * ra; sv[n] = rb; }
                    {
                        const unsigned vg = (unsigned)(((wr * 4 + wc) * 64 + fq * 16 + fr) * 16), sg = ((((unsigned)u.pm * 16u + (unsigned)(cb >> 7)) * 2u + ai) * 4u + m) * 8192u;
                        bst16(pack8(rv[0], rv[1]), ro, vg, sg); bst16(pack8(sv[0], sv[1]), ro, vg, sg + (unsigned)((size_t)M * DM * 2)); }
                    continue; }
                f32x4 c0, c1, s0, s1;
                if (rope) { c0 = __builtin_bit_cast(f32x4, bld16(rc, vc, sc + rofs * 64u)); c1 = __builtin_bit_cast(f32x4, bld16(rc, vc, sc + rofs * 64u + 16u)); s0 = __builtin_bit_cast(f32x4, bld16(rc, vc, sc + rofs * 64u + 32u)); s1 = __builtin_bit_cast(f32x4, bld16(rc, vc, sc + rofs * 64u + 48u));
                    if (fq == 0) { s0 = -s0; s1 = -s1; } }
                float z1 = 0.f, z2 = 0.f;
#pragma unroll
                for (int bj = 0; bj < 2; ++bj) { f32x4 v0 = acc[ai][bj][m][0] * rs + bv[bj][0], v1 = acc[ai][bj][m][1] * rs + bv[bj][1];
                    if (rope) { f32x4 p0, p1;
#pragma unroll
                        for (int j = 0; j < 4; ++j) { p0[j] = __shfl_xor(v0[j], 16); p1[j] = __shfl_xor(v1[j], 16); }
                        if (fq < 2) { v0 = v0 * c0 + p0 * s0; v1 = v1 * c1 + p1 * s1; } }
                    if (mode == 1) { f32x2 a = gelu_pk((f32x2){v0[0], v0[1]}), b = gelu_pk((f32x2){v0[2], v0[3]}), c = gelu_pk((f32x2){v1[0], v1[1]}), d = gelu_pk((f32x2){v1[2], v1[3]});
                        v0 = (f32x4){a.x, a.y, b.x, b.y}; v1 = (f32x4){c.x, c.y, d.x, d.y};
                        if (vstat) { z1 += (v0[0] + v0[1]) + (v0[2] + v0[3]) + (v1[0] + v1[1]) + (v1[2] + v1[3]);
                            z2 += (v0[0] * v0[0] + v0[1] * v0[1]) + (v0[2] * v0[2] + v0[3] * v0[3]) + (v1[0] * v1[0] + v1[1] * v1[1]) + (v1[2] * v1[2] + v1[3] * v1[3]); } }
                    bst16(pack8(v0, v1), ro, vo, so + (rofs * ldc + bj * HALF) * 2u); }
                if (vstat) { z1 += __shfl_xor(z1, 16); z1 += __shfl_xor(z1, 32); z2 += __shfl_xor(z2, 16); z2 += __shfl_xor(z2, 32);
                    const size_t r = (size_t)u.pm * BM + lrow + rofs;
                    if (fq == 0) { fx_add(zst + r * 2, z1, FX_ZST); fx_add(zst + r * 2 + 1, z2, FX_ZST); } } }
    }
};
struct EpiGate {
    static constexpr bool PERM = true, AFTER_DRAIN = false; static constexpr int MID_T = AW / BK; static constexpr bool BLOCKED = false;
    const bf16_t* gr; const bf16_t* gs; bf16_t* mg;
    __device__ __forceinline__ void mid(f32x4 (&acc)[2][2][4][2], const Unit& u, int wr, int wc, int fr, int fq) const {
        const rsrc_t rg = mk_rsrc(gr, (size_t)M * DM * 2);
        const unsigned vg = (unsigned)(((wr * 4 + wc) * 64 + fq * 16 + fr) * 16);
        const unsigned vo = ((wr * 64 + fr) * DM + wc * 32 + 8 * fq) * 2u, so = ((unsigned)u.pm * BM * DM + (unsigned)u.pn * BM) * 2u;
#pragma unroll
        for (int ai = 0; ai < 2; ++ai) { v4u gw[4][2];
#pragma unroll
            for (int m = 0; m < 4; ++m)
#pragma unroll
                for (int bj = 0; bj < 2; ++bj) gw[m][bj] = bld16(rg, vg, ((((unsigned)u.pm * 16u + 2u * (unsigned)u.pn + bj) * 2u + ai) * 4u + m) * 8192u);
#pragma unroll
            for (int m = 0; m < 4; ++m)
#pragma unroll
                for (int bj = 0; bj < 2; ++bj) { acc[ai][bj][m][0] *= unlo(gw[m][bj]); acc[ai][bj][m][1] *= unhi(gw[m][bj]); } }
    }
    __device__ __forceinline__ void operator()(const f32x4 (&acc)[2][2][4][2], const Unit& u, int wr, int wc, int fr, int fq) const {
        const rsrc_t rg = mk_rsrc(gs, (size_t)M * DM * 2), ro = mk_rsrc(mg, (size_t)M * DM * 2);
        const unsigned vg = (unsigned)(((wr * 4 + wc) * 64 + fq * 16 + fr) * 16);
        const unsigned vo = ((wr * 64 + fr) * DM + wc * 32 + 8 * fq) * 2u, so = ((unsigned)u.pm * BM * DM + (unsigned)u.pn * BM) * 2u;
        const unsigned vb_ = epi_img_byte(wr, wc, fr, fq) >> 1, sb_ = ((unsigned)u.pm * 2u * (DM / 64) + (unsigned)u.pn * 4u) * 8192u;
        v4u gw[2][4][2];
#pragma unroll
        for (int ai = 0; ai < 2; ++ai)
#pragma unroll
            for (int m = 0; m < 4; ++m)
#pragma unroll
                for (int bj = 0; bj < 2; ++bj) gw[ai][m][bj] = bld16(rg, vg, ((((unsigned)u.pm * 16u + 2u * (unsigned)u.pn + bj) * 2u + ai) * 4u + m) * 8192u);
#pragma unroll
        for (int ai = 0; ai < 2; ++ai)
#pragma unroll
            for (int m = 0; m < 4; ++m)
#pragma unroll
                for (int bj = 0; bj < 2; ++bj) bst16(pack8(acc[ai][bj][m][0] * unlo(gw[ai][m][bj]), acc[ai][bj][m][1] * unhi(gw[ai][m][bj])), ro, vb_ * 2u, (sb_ + ((unsigned)ai * (DM / 64) + 2u * bj) * 8192u + m * 1024u) * 2u);
    }
};
struct EpiResid {
    static constexpr bool PERM = true, AFTER_DRAIN = false; static constexpr int MID_T = 0; static constexpr bool BLOCKED = true;
    float* hout; bf16_t* hb; unsigned long long* ssq_out;
    __device__ __forceinline__ void operator()(const f32x4 (&acc)[2][2][4][2], const Unit& u, int wr, int wc, int fr, int fq) const {
        const rsrc_t rh = mk_rsrc(hout, 0), rb = mk_rsrc(hb, 0);
        const unsigned lrow = wr * 64 + fr, ve = lrow * DM + wc * 32 + 8 * fq, se = (unsigned)u.pm * BM * DM + (unsigned)u.pn * BM;
        const unsigned vb_ = epi_img_byte(wr, wc, fr, fq) >> 1, sb_ = ((unsigned)u.pm * 2u * (DM / 64) + (unsigned)u.pn * 4u) * 8192u;
        const bool out32 = hout != nullptr;
        v4u tb[2][4][2];
#pragma unroll
        for (int ai = 0; ai < 2; ++ai)
#pragma unroll
            for (int m = 0; m < 4; ++m)
#pragma unroll
                for (int bj = 0; bj < 2; ++bj) tb[ai][m][bj] = bld16(rb, vb_ * 2u, (sb_ + ((unsigned)ai * (DM / 64) + 2u * bj) * 8192u + m * 1024u) * 2u);
#pragma unroll
        for (int ai = 0; ai < 2; ++ai)
#pragma unroll
            for (int m = 0; m < 4; ++m) { float sq = 0.f;
#pragma unroll
                for (int bj = 0; bj < 2; ++bj) { const unsigned e = se + (ai * HALF + m * 16) * DM + bj * HALF, eb = sb_ + ((unsigned)ai * (DM / 64) + 2u * bj) * 8192u + m * 1024u;
                    const f32x4 v0 = acc[ai][bj][m][0] + unlo(tb[ai][m][bj]), v1 = acc[ai][bj][m][1] + unhi(tb[ai][m][bj]);
                    if (out32) { bst16(__builtin_bit_cast(v4u, v0), rh, ve * 4u, e * 4u); bst16(__builtin_bit_cast(v4u, v1), rh, ve * 4u, e * 4u + 16u); }
                    sq += (v0[0] * v0[0] + v0[1] * v0[1]) + (v0[2] * v0[2] + v0[3] * v0[3]) + (v1[0] * v1[0] + v1[1] * v1[1]) + (v1[2] * v1[2] + v1[3] * v1[3]);
                    bst16(pack8(v0, v1), rb, vb_ * 2u, eb * 2u); }
                sq += __shfl_xor(sq, 16); sq += __shfl_xor(sq, 32);
                if (fq == 0) fx_add(ssq_out + (size_t)u.pm * BM + lrow + ai * HALF + m * 16, sq, FX_SSQ); }
    }
};
struct EpiSwiglu {
    static constexpr bool PERM = true, AFTER_DRAIN = false; static constexpr int MID_T = 0; static constexpr bool BLOCKED = false;
    const unsigned long long* ssq; bf16_t* act;
    __device__ __forceinline__ void operator()(const f32x4 (&acc)[2][2][4][2], const Unit& u, int wr, int wc, int fr, int fq) const {
        const rsrc_t ro = mk_rsrc(act, (size_t)M * DFF * 2), rq = mk_rsrc(ssq, (size_t)M * 8);
        const unsigned lrow = wr * 64 + fr, vo = epi_img_byte(wr, wc, fr, fq), so = (((unsigned)u.pm * 2u * (DFF / 64) + (unsigned)u.pn * 2u) * 8192u) * 2u, vq = lrow * 8u, sq = (unsigned)u.pm * BM * 8u;
        v2u sw[2][4];
#pragma unroll
        for (int ai = 0; ai < 2; ++ai)
#pragma unroll
            for (int m = 0; m < 4; ++m) sw[ai][m] = bld8(rq, vq, sq + (ai * HALF + m * 16) * 8u);
#pragma unroll
        for (int ai = 0; ai < 2; ++ai)
#pragma unroll
            for (int m = 0; m < 4; ++m) { const float rs = rstd_from_bits(sw[ai][m]); const float c1 = rs * -1.4426950408889634f, rs2 = rs * rs;
                const f32x4 a0 = acc[ai][0][m][0], a1 = acc[ai][0][m][1];
                f32x4 e0 = a0 * c1, e1 = a1 * c1; PIN2(e0, e1);
#pragma unroll
                for (int j = 0; j < 4; ++j) { e0[j] = __builtin_amdgcn_exp2f(e0[j]); e1[j] = __builtin_amdgcn_exp2f(e1[j]); }
                f32x4 p0 = a0 * acc[ai][1][m][0], p1 = a1 * acc[ai][1][m][1]; p0 *= rs2; p1 *= rs2;
                e0 += 1.0f; e1 += 1.0f; PIN2(e0, e1);
#pragma unroll
                for (int j = 0; j < 4; ++j) { e0[j] = __builtin_amdgcn_rcpf(e0[j]); e1[j] = __builtin_amdgcn_rcpf(e1[j]); }
                PIN2(e0, e1);
                bst16nt(pack8(p0 * e0, p1 * e1), ro, vo, so + ((unsigned)ai * (DFF / 64) * 8192u + m * 16 * 64u) * 2u); }
    }
};
}

struct Frame {
    LAS unsigned char* lds; volatile LAS unsigned* MISC; gu32* ctl;
    int tid, lane, wave, vcu, G;
};
struct Args { const void* in[17]; float* out; unsigned char* ws; int ph_lo, ph_hi, li, pad; };
enum { I_X = 0, I_POS, I_N1G, I_WIN, I_BIN, I_SINKS, I_LNG, I_LNB, I_SGUW, I_SGUB, I_WAB, I_WSB, I_WOUT, I_N2G, I_WGU, I_WDN, I_FG };

constexpr int TP_PITCH = 272, TP_SCR_BYTES = 32 * TP_PITCH;
typedef short s16x4_t __attribute__((ext_vector_type(4)));
__device__ __forceinline__ void transpose_item(const float* W, int K, int N, bf16* WT, int ldk, int koff, const float* gain, int mode, LAS float* scr_, int item, int lane) {
    LAS unsigned char* scr = (LAS unsigned char*)scr_;
    const int nblk = N / 128, kb = item / nblk, nb = item % nblk, k0 = 32 * kb, n0 = 128 * nb;
    const int kr = lane >> 5, n4 = lane & 31;
    const float* src = W + (size_t)(k0 + kr) * N + n0 + 4 * n4;
    f32x4 v[16];
#pragma unroll
    for (int i = 0; i < 16; ++i) v[i] = __builtin_nontemporal_load((const f32x4*)(src + (size_t)(2 * i) * N));
    if (gain) {
#pragma unroll
        for (int i = 0; i < 16; ++i) v[i] *= gain[k0 + 2 * i + kr]; }
#pragma unroll
    for (int i = 0; i < 16; ++i) *(LAS v2u*)(scr + (2 * i + kr) * TP_PITCH + 8 * n4) = (v2u){pg8::cvtpk(v[i][0], v[i][1]), pg8::cvtpk(v[i][2], v[i][3])};
    LDS_WAIT(); asm volatile("" ::: "memory");
    int d0 = n0;
    if (mode == 1) { const int bj = n0 / DFF, rem = n0 % DFF; d0 = 256 * (rem / 128) + 128 * bj; }
    if (mode == 2 && n0 >= OFF_G) { const int rel = n0 - OFF_G, bj = rel / DM, rem = rel % DM; d0 = OFF_G + 256 * (rem / 128) + 128 * bj; }
    GAS unsigned char* dst = (GAS unsigned char*)(WT + ((size_t)(d0 >> 7) * (ldk / 64) + (koff + k0) / 64) * 8192) + (((koff + k0) >> 5) & 1) * 1024;
    const int fr = lane & 15, fq = lane >> 4, q = fr >> 2, p = fr & 3;
    const unsigned ob = (unsigned)((fr * 64 + fq * 16) ^ ((fr >> 3) << 5));
#pragma unroll
    for (int G = 0; G < 8; ++G) {
        const LAS unsigned char* tp = scr + (8 * fq + q) * TP_PITCH + (32 * (G >> 1) + 8 * p + 4 * (G & 1)) * 2;
        const s16x4_t lo = __builtin_amdgcn_ds_read_tr16_b64_v4i16((LAS s16x4_t*)tp), hi = __builtin_amdgcn_ds_read_tr16_b64_v4i16((LAS s16x4_t*)(tp + 4 * TP_PITCH));
        const v2u l2 = __builtin_bit_cast(v2u, lo), h2 = __builtin_bit_cast(v2u, hi);
        *(GAS v4u*)(dst + G * 2048 + ob) = (v4u){l2.x, l2.y, h2.x, h2.y}; }
    LDS_WAIT(); asm volatile("" ::: "memory");
}
__device__ __forceinline__ void sincos_red(float ang, float& c, float& s) {
    const double a = (double)ang; const double kq = __builtin_rint(a * 0.63661977236758134308);
    const double r = __builtin_fma(-kq, 1.57079632679489661923, a) - kq * 6.123233995736766e-17; const double r2 = r * r;
    double sp = -2.5052108385441718775e-8; sp = sp * r2 + 2.7557319223985890653e-6; sp = sp * r2 - 1.9841269841269841253e-4; sp = sp * r2 + 8.3333333333333332177e-3; sp = sp * r2 - 1.6666666666666665741e-1; sp = r + r * r2 * sp;
    double cp = 2.0876756987868098979e-9; cp = cp * r2 - 2.7557319223985890653e-7; cp = cp * r2 + 2.4801587301587301566e-5; cp = cp * r2 - 1.3888888888888889419e-3; cp = cp * r2 + 4.1666666666666664354e-2; cp = cp * r2 - 0.5; cp = 1.0 + r2 * cp;
    const int qd = ((int)(long long)kq) & 3;
    const double cs = (qd & 1) ? sp : cp, sn = (qd & 1) ? cp : sp;
    c = (float)((qd == 1 || qd == 2) ? -cs : cs); s = (float)((qd >= 2) ? -sn : sn);
}

constexpr int CI_IN = (DM / 64) * (INW / 64), CI_AB = (AW / 64) * (DM / 64), CI_SB = (SGUW / 64) * (DM / 64), CI_OUT = (DM / 64) * (DM / 64), CI_GU = (DM / 64) * (2 * DFF / 64), CI_DN = (DFF / 64) * (DM / 64);
constexpr int CI_LAYER = CI_IN + CI_AB + CI_SB + CI_OUT + CI_GU + CI_DN;
constexpr int CI_IDLE_PER_WAVE = 5;
__device__ __forceinline__ void convert_item(const Args& args, unsigned char* ws, int l, int r, LAS float* scr, int lane) {
    unsigned char* wl = ws + WS_W + (size_t)l * W_LAYER;
    const float* W; int K, N, ldk, koff = 0, mode = 0; bf16* WT; const float* gain = nullptr;
    if (r < CI_IN) { W = (const float*)args.in[I_WIN] + (size_t)l * DM * INW; K = DM; N = INW; WT = (bf16*)(wl + WL_IN); ldk = DM; gain = (const float*)args.in[I_N1G] + l * DM; mode = 2; }
    else if ((r -= CI_IN) < CI_AB) { W = (const float*)args.in[I_WAB] + (size_t)l * AW * DM; K = AW; N = DM; WT = (bf16*)(wl + WL_AB); ldk = DM; }
    else if ((r -= CI_AB) < CI_SB) { W = (const float*)args.in[I_WSB] + (size_t)l * SGUW * DM; K = SGUW; N = DM; WT = (bf16*)(wl + WL_AB); ldk = DM; koff = AW; }
    else if ((r -= CI_SB) < CI_OUT) { W = (const float*)args.in[I_WOUT] + (size_t)l * DM * DM; K = DM; N = DM; WT = (bf16*)(wl + WL_OUT); ldk = DM; }
    else if ((r -= CI_OUT) < CI_GU) { W = (const float*)args.in[I_WGU] + (size_t)l * DM * 2 * DFF; K = DM; N = 2 * DFF; WT = (bf16*)(wl + WL_GU); ldk = DM; gain = (const float*)args.in[I_N2G] + l * DM; mode = 1; }
    else { r -= CI_GU; W = (const float*)args.in[I_WDN] + (size_t)l * DFF * DM; K = DFF; N = DM; WT = (bf16*)(wl + WL_DN); ldk = DFF; }
    transpose_item(W, K, N, WT, ldk, koff, gain, mode, scr, r, lane);
}

constexpr int NPL = 6;
constexpr int N_PHASES = 1 + DEPTH * NPL + 1;

__global__ void __launch_bounds__(NWAVES * 64, 2) fwd(Args args) {
    extern __shared__ __attribute__((aligned(16))) unsigned char lds[];
    Frame F;
    F.lds = (LAS unsigned char*)lds; F.MISC = (volatile LAS unsigned*)(F.lds + MISC_OFF);
    F.tid = threadIdx.x; F.lane = F.tid & 63; F.wave = __builtin_amdgcn_readfirstlane(F.tid >> 6);
    F.G = gridDim.x; { const int bx = blockIdx.x; F.vcu = (F.G % 8 == 0) ? (bx % 8) * (F.G / 8) + bx / 8 : bx; }
    unsigned char* ws = args.ws;
    F.ctl = (gu32*)(ws + WS_CTL);
    for (int u = F.tid; u < (LDS_BYTES - LDSCTL_OFF) / 4; u += NWAVES * 64) ((LAS unsigned*)(F.lds + LDSCTL_OFF))[u] = 0u;
    __syncthreads();
    const int lo = args.ph_lo, hi = args.ph_hi;
    const bool use_bar = (hi - lo) > 1;
    XcdBarrier bar; bar.bar = (unsigned*)(F.ctl + CW_BAR); bar.x = 0; bar.st = nullptr;
    if (use_bar) bar = xcd_barrier_post((unsigned*)(F.ctl + CW_BAR), F.MISC + 8);
    if (use_bar && F.tid == 0) __hip_atomic_store((unsigned*)(F.ctl + CW_XTAB) + blockIdx.x, 1u + xb_xcc_id(), __ATOMIC_RELAXED, __HIP_MEMORY_SCOPE_AGENT);
    bool xl_ok = false;
#define PH_IN(id) (lo <= (id) && (id) < hi)
#define PH_END(id) do { if ((id) + 1 < hi) xcd_barrier(bar, F.wave == 0); } while (0)
#define PH_END_LOCAL(id) do { if ((id) + 1 < hi) { if (xl_ok) xcc_local_barrier((unsigned*)(F.ctl + CW_XL) + 64 * (blockIdx.x & 7), F.MISC + 11, (unsigned)(F.G >> 3), F.wave == 0); else xcd_barrier(bar, F.wave == 0); } } while (0)

    const float* x = (const float*)args.in[I_X]; const int* pos = (const int*)args.in[I_POS];
    float* h = args.out;
    bf16* hb = (bf16*)(ws + WS_HB); bf16* qb = (bf16*)(ws + WS_Q); bf16* kb = (bf16*)(ws + WS_K); bf16* vb = (bf16*)(ws + WS_V);
    bf16* zb = (bf16*)(ws + WS_Z); bf16* gb = (bf16*)(ws + WS_G); bf16* yb = (bf16*)(ws + WS_Y); bf16* mgb = (bf16*)(ws + WS_MG);
    bf16* actb = (bf16*)(ws + WS_ACT); float* tb = (float*)(ws + WS_T);
    float* cs = (float*)(ws + WS_CS); unsigned long long* ssq = (unsigned long long*)(ws + WS_SSQ); unsigned long long* zst = (unsigned long long*)(ws + WS_ZST);
    const int gw = F.vcu * NWAVES + F.wave, NGW = F.G * NWAVES, lane = F.lane;

    if (PH_IN(0)) {
        LAS float* scr = (LAS float*)(F.lds + F.wave * TP_SCR_BYTES);
        const int nwg_in = (M / 256) * (INW / 256), nrounds_in = (nwg_in + F.G - 1) / F.G, n_idle_wg = nrounds_in * F.G - nwg_in, nconv = n_idle_wg > 0 ? (n_idle_wg * NWAVES * CI_IDLE_PER_WAVE < CI_LAYER ? n_idle_wg * NWAVES * CI_IDLE_PER_WAVE : CI_LAYER) : 0;
        const int nrem = CI_LAYER - nconv;
        for (int it = gw; it < DEPTH * nrem; it += NGW) { const int l = DEPTH - 1 - it / nrem, r = nrem - 1 - it % nrem; convert_item(args, ws, l, r, scr, lane); }
        for (int m0 = gw; m0 < M; m0 += 2 * NGW) {
            f32x4 xv[2][8];
#pragma unroll
            for (int r2 = 0; r2 < 2; ++r2) { const int m = (m0 + r2 * NGW < M) ? m0 + r2 * NGW : m0; const GAS f32x4* xr = (const GAS f32x4*)(x + (size_t)m * DM) + lane;
#pragma unroll
                for (int j = 0; j < 8; ++j) xv[r2][j] = __builtin_nontemporal_load(xr + 64 * j); }
#pragma unroll
            for (int r2 = 0; r2 < 2; ++r2) { const int m = m0 + r2 * NGW; if (m < M) {
                GAS v2u* br = (GAS v2u*)(hb + ((size_t)(m >> 7) * (DM / 64) + (lane >> 4)) * 8192 + (pg8::lds_byte(m & 127, 4 * (lane & 15)) >> 1));
                float sq = 0.f;
#pragma unroll
                for (int j = 0; j < 8; ++j) { const f32x4 v = xv[r2][j]; br[(size_t)j * 4 * 8192 / 4] = (v2u){pk2(v.x, v.y), pk2(v.z, v.w)}; sq += (v.x * v.x + v.y * v.y) + (v.z * v.z + v.w * v.w); }
                sq = wave_sum(sq); if (lane == 0) ssq[m] = fx_enc(sq, FX_SSQ); } }
        }
        for (int i = (blockIdx.x * NWAVES * 64 + F.tid); i < DEPTH * SGUG * CHUNK * CHUNK; i += F.G * NWAVES * 64) {
            const int sx = i & 127, t = (i >> 7) & 127; ((bf16*)(ws + WS_SGUWM))[i] = (sx <= t) ? (bf16)f2bf(((const float*)args.in[I_SGUW])[i]) : (bf16)0; }
        for (int i = (blockIdx.x * NWAVES * 64 + F.tid); i < M * 8; i += F.G * NWAVES * 64) {
            const int m = i >> 3, f = i & 7;
            const float invf[8] = {1.0f, 0.1939227432012558f, 0.03760603070259094f, 0.007292664609849453f, 0.0014142135623842478f, 0.00027424818836152554f, 5.318296098266728e-05f, 1.0313386155758053e-05f};
            float fr = invf[0];
#pragma unroll
            for (int q = 1; q < 8; ++q) fr = (f == q) ? invf[q] : fr;
            const float ang = (float)pos[m] * fr; float c, s; sincos_red(ang, c, s);
            cs[m * 16 + f] = c; cs[m * 16 + 8 + f] = s;
        }
        PH_END(0);
        if (use_bar && lo == 0 && hi == N_PHASES && F.G == 256) {
            int bad = 0;
            for (int j = F.tid; j < F.G; j += NWAVES * 64) { const unsigned v = __hip_atomic_load((unsigned*)(F.ctl + CW_XTAB) + j, __ATOMIC_RELAXED, __HIP_MEMORY_SCOPE_AGENT), r = __hip_atomic_load((unsigned*)(F.ctl + CW_XTAB) + (j & 7), __ATOMIC_RELAXED, __HIP_MEMORY_SCOPE_AGENT); bad |= (v == 0u || v != r) ? 1 : 0; }
            xl_ok = !__syncthreads_or(bad);
        }
    }

    for (int l = 0; l < DEPTH; ++l) {
        const int pb = 1 + l * NPL;
        int tid_l = lane_here() + 64 * F.wave; asm volatile("" : "+v"(tid_l));
        const int lane = tid_l & 63, tidl = tid_l;
        unsigned char* wl = ws + WS_W + (size_t)l * W_LAYER;
        if (PH_IN(pb + 0)) {
            pg8::Gemm g{hb, (const bf16*)(wl + WL_IN), M, INW, DM}; pg8::StaticOrder S; S.init(M, INW, F.G, (int)blockIdx.x, 4);
            pg8::EpiInProj E{ssq + (size_t)(2 * l) * M, (const float*)args.in[I_BIN] + l * INW, cs, zst + (size_t)l * M * 2, qb, kb, vb, zb, gb};
            pg8::gemm_phase<pg8::EpiInProj, pg8::StaticOrder, true, true>(F.lds, g, S, E, F.wave);
            {
                const int nwg_in = (M / 256) * (INW / 256), nrounds_in = (nwg_in + F.G - 1) / F.G, n_idle_wg = nrounds_in * F.G - nwg_in, rank = (nrounds_in - 1) * F.G + (int)blockIdx.x - nwg_in;
                if (n_idle_wg > 0 && rank >= 0 && rank < n_idle_wg) {
                    LAS float* scr = (LAS float*)(F.lds + F.wave * TP_SCR_BYTES);
                    const int nconv = n_idle_wg * NWAVES * CI_IDLE_PER_WAVE < CI_LAYER ? n_idle_wg * NWAVES * CI_IDLE_PER_WAVE : CI_LAYER;
                    for (int k = 0; k < CI_IDLE_PER_WAVE; ++k) { const int r = CI_LAYER - nconv + (rank * NWAVES + F.wave) + k * n_idle_wg * NWAVES; if (r < CI_LAYER) convert_item(args, ws, l, r, scr, lane); } } }
            PH_END(pb + 0);
        }
        if (PH_IN(pb + 1)) {
            typedef short s16x8 __attribute__((ext_vector_type(8)));
            typedef float f32x16 __attribute__((ext_vector_type(16)));
            const int q_ = lane & 31, hh = lane >> 5, wave = F.wave;
            const float* sinks = (const float*)args.in[I_SINKS] + l * NQH;
            for (int ua = F.vcu; ua < (M / 128) * NKVH; ua += F.G) {
                const int hk = ua & 3, blk = ua >> 2, nb = blk & 63, b = blk >> 6;
                const size_t row0 = (size_t)b * SEQ + (size_t)nb * 128;
                s16x8 qfa[2][4];
#pragma unroll
                for (int gi = 0; gi < 2; ++gi)
#pragma unroll
                    for (int ks = 0; ks < 4; ++ks) qfa[gi][ks] = *(const GAS s16x8*)(qb + (row0 + 32 * ((wave & 1) * 2 + gi) + q_) * AW + (hk * 4 + (wave >> 1)) * HD + 16 * ks + 8 * hh);
                LDS_WAIT(); __builtin_amdgcn_s_barrier(); asm volatile("" ::: "memory");
#pragma unroll
                for (int p = 0; p < 4; ++p) { const int chunk = p * 512 + tidl, kx = chunk >> 3, dc = chunk & 7; const bool ok = (nb > 0) || (kx >= 128);
                    v4u kv = (v4u){0u, 0u, 0u, 0u}; if (ok) kv = *(const GAS v4u*)(kb + (row0 + kx - 128) * KVW + hk * HD + dc * 8);
                    *(LAS v4u*)(F.lds + P2_K + kx * P2_KROW + dc * 16) = kv; }
#pragma unroll
                for (int p = 0; p < 4; ++p) { const int chunk = p * 512 + tidl, dc = chunk >> 8, kx = chunk & 255; const bool ok = (nb > 0) || (kx >= 128);
                    v4u vv = (v4u){0u, 0u, 0u, 0u}; if (ok) vv = *(const GAS v4u*)(vb + (row0 + kx - 128) * KVW + hk * HD + dc * 8);
                    const int pos = (kx & ~15) + 8 * ((kx >> 2) & 1) + 4 * ((kx >> 3) & 1) + (kx & 3);
                    LAS unsigned short* vp = (LAS unsigned short*)(F.lds + P2_V + (dc * 8) * P2_VROW + pos * 2);
                    vp[0 * (P2_VROW / 2)] = (unsigned short)(vv.x & 0xffffu); vp[1 * (P2_VROW / 2)] = (unsigned short)(vv.x >> 16);
                    vp[2 * (P2_VROW / 2)] = (unsigned short)(vv.y & 0xffffu); vp[3 * (P2_VROW / 2)] = (unsigned short)(vv.y >> 16);
                    vp[4 * (P2_VROW / 2)] = (unsigned short)(vv.z & 0xffffu); vp[5 * (P2_VROW / 2)] = (unsigned short)(vv.z >> 16);
                    vp[6 * (P2_VROW / 2)] = (unsigned short)(vv.w & 0xffffu); vp[7 * (P2_VROW / 2)] = (unsigned short)(vv.w >> 16); }
                LDS_WAIT(); __builtin_amdgcn_s_barrier(); asm volatile("" ::: "memory");
                const int hq = hk * 4 + (wave >> 1);
                const float sink2 = sinks[hq] * 1.4426950408889634f;
#pragma unroll
                for (int gi = 0; gi < 2; ++gi) {
                    const int tg = (wave & 1) * 2 + gi; const size_t trow = row0 + 32 * tg + q_;
                    s16x8 qf[4];
#pragma unroll
                    for (int ks = 0; ks < 4; ++ks) qf[ks] = qfa[gi][ks];
                    f32x16 st[5];
#pragma unroll
                    for (int jt = 0; jt < 5; ++jt) { const int kt = tg + jt; f32x16 a = {};
#pragma unroll
                        for (int ks = 0; ks < 4; ++ks) { const s16x8 kf = *(const LAS s16x8*)(F.lds + P2_K + (32 * kt + q_) * P2_KROW + (16 * ks + 8 * hh) * 2);
                            a = __builtin_amdgcn_mfma_f32_32x32x16_bf16(kf, qf[ks], a, 0, 0, 0); }
                        st[jt] = a; }
                    const float c2 = 0.125f * 1.4426950408889634f; const float NEGINF = -__builtin_inff();
                    float mx = sink2;
#pragma unroll
                    for (int jt = 0; jt < 5; ++jt) { const bool dead = (nb == 0) && (tg + jt < 4);
#pragma unroll
                        for (int r = 0; r < 16; ++r) { const int i = (r & 3) + 8 * (r >> 2) + 4 * hh; bool ok = !dead; if (jt == 0) ok = ok && (i > q_); if (jt == 4) ok = ok && (i <= q_);
                            const float v = ok ? st[jt][r] * c2 : NEGINF; st[jt][r] = v; mx = fmaxf(mx, v); } }
                    mx = fmaxf(mx, __shfl_xor(mx, 32));
                    float lsum = 0.f;
#pragma unroll
                    for (int jt = 0; jt < 5; ++jt)
#pragma unroll
                        for (int r = 0; r < 16; ++r) { const float pe = __builtin_amdgcn_exp2f(st[jt][r] - mx); st[jt][r] = pe; lsum += pe; }
                    lsum += __shfl_xor(lsum, 32); lsum += __builtin_amdgcn_exp2f(sink2 - mx);
                    f32x16 o0 = {}, o1 = {};
#pragma unroll
                    for (int jt = 0; jt < 5; ++jt) { const int kt = tg + jt;
#pragma unroll
                        for (int sp = 0; sp < 2; ++sp) {
                            v4u pw; pw.x = pg8::cvt_pk_bf16(st[jt][8 * sp + 0], st[jt][8 * sp + 1]); pw.y = pg8::cvt_pk_bf16(st[jt][8 * sp + 2], st[jt][8 * sp + 3]);
                            pw.z = pg8::cvt_pk_bf16(st[jt][8 * sp + 4], st[jt][8 * sp + 5]); pw.w = pg8::cvt_pk_bf16(st[jt][8 * sp + 6], st[jt][8 * sp + 7]);
                            const s16x8 pf = __builtin_bit_cast(s16x8, pw);
                            const s16x8 v0 = *(const LAS s16x8*)(F.lds + P2_V + (q_) * P2_VROW + (32 * kt + 16 * sp + 8 * hh) * 2);
                            const s16x8 v1 = *(const LAS s16x8*)(F.lds + P2_V + (32 + q_) * P2_VROW + (32 * kt + 16 * sp + 8 * hh) * 2);
                            o0 = __builtin_amdgcn_mfma_f32_32x32x16_bf16(v0, pf, o0, 0, 0, 0);
                            o1 = __builtin_amdgcn_mfma_f32_32x32x16_bf16(v1, pf, o1, 0, 0, 0); } }
                    const float inv = 1.0f / lsum;
#pragma unroll
                    for (int rq = 0; rq < 4; ++rq) {
                        *(GAS v2u*)(yb + blk_idx(trow, hq * HD + 4 * hh + 8 * rq, DM)) = (v2u){pg8::cvt_pk_bf16(o0[4 * rq + 0] * inv, o0[4 * rq + 1] * inv), pg8::cvt_pk_bf16(o0[4 * rq + 2] * inv, o0[4 * rq + 3] * inv)};
                        *(GAS v2u*)(yb + blk_idx(trow, hq * HD + 32 + 4 * hh + 8 * rq, DM)) = (v2u){pg8::cvt_pk_bf16(o1[4 * rq + 0] * inv, o1[4 * rq + 1] * inv), pg8::cvt_pk_bf16(o1[4 * rq + 2] * inv, o1[4 * rq + 3] * inv)}; }
                }
            }
            const float* lng = (const float*)args.in[I_LNG] + l * SGUW; const float* lnb = (const float*)args.in[I_LNB] + l * SGUW;
            const float* sbias = (const float*)args.in[I_SGUB] + l * SGUG * CHUNK;
            const bf16* wm_l = (const bf16*)(ws + WS_SGUWM) + (size_t)l * SGUG * CHUNK * CHUNK;
            bf16* ys = yb + AW;
            {
                constexpr int NU = (M / CHUNK) * SGUG;
                const int ct = wave & 3, tt0 = wave >> 2, tt1 = 3 - tt0;
                LAS float* lnp = (LAS float*)(F.lds + P2_LN);
                v4u zv[4], zs[4]; int gcur = -1;
                int us = F.vcu;
#define SGU_ISSUE(us_) do { const int g_ = (us_) & 7; const size_t base_ = (size_t)((us_) >> 3) * CHUNK; \
                    _Pragma("unroll") for (int p = 0; p < 4; ++p) { const int c = p * 512 + tidl, cc = c >> 7, sx = c & 127; \
                        zv[p] = *(const GAS v4u*)(zb + (base_ + sx) * (2 * SGUW) + SGUW + 128 * g_ + cc * 8); zs[p] = *(const GAS v4u*)(zst + ((size_t)l * M + base_ + sx) * 2); } } while (0)
                if (us < NU) SGU_ISSUE(us);
                for (; us < NU; us += F.G) {
                    const int g = us & 7, chunk = us >> 3; const size_t base = (size_t)chunk * CHUNK;
                    v2u uw[2][4];
#pragma unroll
                    for (int ti = 0; ti < 2; ++ti)
#pragma unroll
                        for (int rq = 0; rq < 4; ++rq) uw[ti][rq] = *(const GAS v2u*)(zb + (base + 32 * (ti == 0 ? tt0 : tt1) + q_) * (2 * SGUW) + 128 * g + 32 * ct + 4 * hh + 8 * rq);
                    LDS_WAIT(); __builtin_amdgcn_s_barrier(); asm volatile("" ::: "memory");
                    if (g != gcur) {
                        gcur = g; const bf16* wm = wm_l + (size_t)g * CHUNK * CHUNK;
                        if (tidl < 256) lnp[tidl] = (tidl < 128) ? lng[128 * g + tidl] : lnb[128 * g + tidl - 128];
#pragma unroll
                        for (int p = 0; p < 4; ++p) { const int c = p * 512 + tidl, t = c >> 4, sc = c & 15;
                            *(LAS v4u*)(F.lds + P2_WM + t * P2_SROW + sc * 16) = *(const GAS v4u*)(wm + (size_t)t * CHUNK + sc * 8); }
                        LDS_WAIT(); __builtin_amdgcn_s_barrier(); asm volatile("" ::: "memory"); }
#pragma unroll
                    for (int p = 0; p < 4; ++p) { const int c = p * 512 + tidl, cc = c >> 7, sx = c & 127;
                        const unsigned long long z0 = (unsigned long long)zs[p].x | ((unsigned long long)zs[p].y << 32), z1 = (unsigned long long)zs[p].z | ((unsigned long long)zs[p].w << 32);
                        const double zm = (double)(long long)z0 * (1.0 / (FX_ZST * SGUW)); const double zvar = (double)(long long)z1 * (1.0 / (FX_ZST * SGUW)) - zm * zm; const float mm = (float)zm, rs = 1.0f / sqrtf((float)zvar + EPS);
                        const f32x4 g0 = *(const LAS f32x4*)(lnp + cc * 8), g1 = *(const LAS f32x4*)(lnp + cc * 8 + 4), b0 = *(const LAS f32x4*)(lnp + 128 + cc * 8), b1 = *(const LAS f32x4*)(lnp + 128 + cc * 8 + 4);
                        const v4u zw = zv[p];
                        LAS unsigned short* vp = (LAS unsigned short*)(F.lds + (cc * 8) * P2_SROW + sx * 2);
                        vp[0 * (P2_SROW / 2)] = (unsigned short)f2bf((bflo(zw.x) - mm) * rs * g0[0] + b0[0]); vp[1 * (P2_SROW / 2)] = (unsigned short)f2bf((bfhi(zw.x) - mm) * rs * g0[1] + b0[1]);
                        vp[2 * (P2_SROW / 2)] = (unsigned short)f2bf((bflo(zw.y) - mm) * rs * g0[2] + b0[2]); vp[3 * (P2_SROW / 2)] = (unsigned short)f2bf((bfhi(zw.y) - mm) * rs * g0[3] + b0[3]);
                        vp[4 * (P2_SROW / 2)] = (unsigned short)f2bf((bflo(zw.z) - mm) * rs * g1[0] + b1[0]); vp[5 * (P2_SROW / 2)] = (unsigned short)f2bf((bfhi(zw.z) - mm) * rs * g1[1] + b1[1]);
                        vp[6 * (P2_SROW / 2)] = (unsigned short)f2bf((bflo(zw.w) - mm) * rs * g1[2] + b1[2]); vp[7 * (P2_SROW / 2)] = (unsigned short)f2bf((bfhi(zw.w) - mm) * rs * g1[3] + b1[3]); }
                    if (us + F.G < NU) SGU_ISSUE(us + F.G);
                    LDS_WAIT(); __builtin_amdgcn_s_barrier(); asm volatile("" ::: "memory");
                    f32x16 a0 = {}, a1 = {};
#pragma unroll
                    for (int sk = 0; sk < 8; ++sk) { const s16x8 af = *(const LAS s16x8*)(F.lds + (32 * ct + q_) * P2_SROW + (16 * sk + 8 * hh) * 2);
                        if (sk < 4) a0 = __builtin_amdgcn_mfma_f32_32x32x16_bf16(af, *(const LAS s16x8*)(F.lds + P2_WM + (32 * tt0 + q_) * P2_SROW + (16 * sk + 8 * hh) * 2), a0, 0, 0, 0);
                        a1 = __builtin_amdgcn_mfma_f32_32x32x16_bf16(af, *(const LAS s16x8*)(F.lds + P2_WM + (32 * tt1 + q_) * P2_SROW + (16 * sk + 8 * hh) * 2), a1, 0, 0, 0); }
#pragma unroll
                    for (int ti = 0; ti < 2; ++ti) { const int tt = ti == 0 ? tt0 : tt1; const f32x16 a = ti == 0 ? a0 : a1;
                        const int t = 32 * tt + q_; const size_t row = base + t; const float bs = sbias[g * CHUNK + t];
                        const int ch0 = 128 * g + 32 * ct + 4 * hh;
#pragma unroll
                        for (int rq = 0; rq < 4; ++rq) { const v2u u2 = uw[ti][rq];
                            *(GAS v2u*)(yb + blk_idx(row, AW + ch0 + 8 * rq, DM)) = (v2u){pg8::cvt_pk_bf16(bflo(u2.x) * (a[4 * rq + 0] + bs), bfhi(u2.x) * (a[4 * rq + 1] + bs)), pg8::cvt_pk_bf16(bflo(u2.y) * (a[4 * rq + 2] + bs), bfhi(u2.y) * (a[4 * rq + 3] + bs))}; } }
                }
#undef SGU_ISSUE
            }
            LDS_WAIT(); __builtin_amdgcn_s_barrier(); asm volatile("" ::: "memory");
            PH_END(pb + 1);
        }
        if (PH_IN(pb + 2)) {
            pg8::Gemm g{yb, (const bf16*)(wl + WL_AB), M, DM, DM}; pg8::StaticOrder S; S.init(M, DM, F.G, (int)blockIdx.x, 4);
            pg8::EpiGate E{gb, gb + (size_t)M * DM, mgb};
            pg8::gemm_phase<pg8::EpiGate, pg8::StaticOrder, true, true>(F.lds, g, S, E, F.wave);
            PH_END_LOCAL(pb + 2);
        }
        if (PH_IN(pb + 3)) {
            pg8::Gemm g{mgb, (const bf16*)(wl + WL_OUT), M, DM, DM}; pg8::StaticOrder S; S.init(M, DM, F.G, (int)blockIdx.x, 4);
            pg8::EpiResid E{nullptr, hb, ssq + (size_t)(2 * l + 1) * M};
            pg8::gemm_phase<pg8::EpiResid, pg8::StaticOrder, true, true>(F.lds, g, S, E, F.wave);
            PH_END_LOCAL(pb + 3);
        }
        if (PH_IN(pb + 4)) {
            pg8::Gemm g{hb, (const bf16*)(wl + WL_GU), M, 2 * DFF, DM}; pg8::StaticOrder S; S.init(M, 2 * DFF, F.G, (int)blockIdx.x, 4);
            pg8::EpiSwiglu E{ssq + (size_t)(2 * l + 1) * M, actb};
            pg8::gemm_phase<pg8::EpiSwiglu, pg8::StaticOrder, true, true>(F.lds, g, S, E, F.wave);
            PH_END_LOCAL(pb + 4);
        }
        if (PH_IN(pb + 5)) {
            pg8::Gemm g{actb, (const bf16*)(wl + WL_DN), M, DM, DFF}; pg8::StaticOrder S; S.init(M, DM, F.G, (int)blockIdx.x, 4);
            pg8::EpiResid E{nullptr, hb, ssq + (size_t)(2 * l + 2) * M};
            pg8::gemm_phase<pg8::EpiResid, pg8::StaticOrder, true, true>(F.lds, g, S, E, F.wave);
            if (l + 1 < DEPTH) PH_END_LOCAL(pb + 5); else PH_END(pb + 5);
        }
    }
    if (PH_IN(N_PHASES - 1)) {
        const float* fg = (const float*)args.in[I_FG];
        int lane_f = lane_here(); asm volatile("" : "+v"(lane_f));
        const int lane = lane_f;
        const int NGWF = F.G * NWAVES;
        for (int m0 = F.vcu * NWAVES + F.wave; m0 < M; m0 += 2 * NGWF) {
            v2u hw[2][8]; float rs[2];
#pragma unroll
            for (int r2 = 0; r2 < 2; ++r2) { const int m = (m0 + r2 * NGWF < M) ? m0 + r2 * NGWF : m0;
                const GAS v2u* br = (const GAS v2u*)(hb + ((size_t)(m >> 7) * (DM / 64) + (lane >> 4)) * 8192 + (pg8::lds_byte(m & 127, 4 * (lane & 15)) >> 1));
#pragma unroll
                for (int j = 0; j < 8; ++j) hw[r2][j] = br[(size_t)j * 8192];
                rs[r2] = rstd_from_ssq(ssq + (size_t)(2 * DEPTH) * M + m); }
            const GAS f32x4* gr = (const GAS f32x4*)fg + lane;
#pragma unroll
            for (int r2 = 0; r2 < 2; ++r2) { const int m = m0 + r2 * NGWF; if (m < M) { GAS f32x4* orow = (GAS f32x4*)(h + (size_t)m * DM) + lane;
#pragma unroll
                for (int j = 0; j < 8; ++j) { const v2u w = hw[r2][j]; const f32x4 v = (f32x4){bflo(w.x), bfhi(w.x), bflo(w.y), bfhi(w.y)}; orow[64 * j] = v * rs[r2] * gr[64 * j]; } } } }
    }
#undef PH_IN
#undef PH_END
#undef PH_END_LOCAL
}

extern "C" void kernel_launch(void* const* d_in, const int* in_sizes, int n_in, void* d_out, int out_size, void* d_ws, size_t ws_size, hipStream_t stream) {
    static int grid = 0;
    if (grid == 0) {
        if (n_in != 17 || in_sizes[0] != M * DM || out_size != M * DM || ws_size < WS_END) { fprintf(stderr, "kernel_launch: unexpected shapes (n_in %d, in0 %d, out %d, ws %zu < %zu); nothing launched\n", n_in, n_in > 0 ? in_sizes[0] : -1, out_size, ws_size, (size_t)WS_END); grid = -1; return; }
        int dev = 0, cus = 0, per_cu = 0;
        if (hipGetDevice(&dev) != hipSuccess || hipDeviceGetAttribute(&cus, hipDeviceAttributeMultiprocessorCount, dev) != hipSuccess) { grid = -1; return; }
        if (hipFuncSetAttribute((const void*)fwd, hipFuncAttributeMaxDynamicSharedMemorySize, LDS_BYTES) != hipSuccess) { fprintf(stderr, "kernel_launch: hipFuncSetAttribute failed\n"); grid = -1; return; }
        if (hipOccupancyMaxActiveBlocksPerMultiprocessor(&per_cu, (const void*)fwd, NWAVES * 64, LDS_BYTES) != hipSuccess || per_cu < 1) fprintf(stderr, "kernel_launch: occupancy query reports %d\n", per_cu);
        (void)hipGetLastError();
        grid = cus;
    }
    if (grid < 0) return;
    if (hipMemsetAsync((char*)d_ws + WS_CTL, 0, CTL_ZERO_BYTES, stream) != hipSuccess) return;
    Args a{};
    for (int i = 0; i < 17; ++i) a.in[i] = d_in[i];
    a.out = (float*)d_out; a.ws = (unsigned char*)d_ws; a.li = 0; a.pad = 0;
#if MK_ONE_LAUNCH
    a.ph_lo = 0; a.ph_hi = N_PHASES;
    hipLaunchKernelGGL(fwd, dim3(grid), dim3(NWAVES * 64), LDS_BYTES, stream, a);
#else
    for (int p = 0; p < N_PHASES; ++p) { a.ph_lo = p; a.ph_hi = p + 1; hipLaunchKernelGGL(fwd, dim3(grid), dim3(NWAVES * 64), LDS_BYTES, stream, a); }
#endif
}
```

```cpp
#include <hip/hip_runtime.h>
#include <cstdio>
#include <cstdint>
__device__ __forceinline__ int lane_here() { unsigned z = 0u; asm volatile("" : "+v"(z)); return (int)__builtin_amdgcn_mbcnt_hi(~0u, __builtin_amdgcn_mbcnt_lo(~0u, z)); }
namespace pg8 {
#define PG8_LAS __attribute__((address_space(3)))
typedef unsigned short bf16_t;
typedef short bf16x8 __attribute__((ext_vector_type(8)));
typedef float f32x4 __attribute__((ext_vector_type(4)));
typedef unsigned u32x4 __attribute__((ext_vector_type(4)));
constexpr int BM = 256, BK = 64, HALF = 128, HTB = HALF * BK * 2  , STAGE_BYTES = 8 * HTB, NXCD = 8, WGM = 8;

__host__ __device__ __forceinline__ int lds_byte(int r, int c) { const int st = (r >> 4) * 2 + (c >> 5), rr = r & 15, cc = c & 31, ob = rr * 64 + cc * 2; return st * 1024 + (ob ^ (((ob >> 9) & 1) << 5)); }
__host__ __device__ __forceinline__ void stage_rc(int b, int& R, int& C) { const int st = b / 1024, sb = b % 1024, swz = sb ^ (((sb >> 9) & 1) << 5); R = (st >> 1) * 16 + swz / 64; C = (st & 1) * 32 + (swz % 64) / 2; }
__host__ __device__ __forceinline__ int perm32(int rho) { const int n = rho >> 4, i = rho & 15; return 8 * (i >> 2) + 4 * n + (i & 3); }

struct Unit { int pm, pn; };
struct Gemm { const bf16_t* A; const bf16_t* Bt; int M, N, K; };

struct StaticOrder {
    int nM, nN, nwg, G, c, wgm;
    __host__ __device__ void init(int M, int N, int G_, int c_, int wgm_ = WGM) { nM = M / BM; nN = N / BM; nwg = nM * nN; G = G_; c = c_; wgm = wgm_; }
    __host__ __device__ bool next(int i, Unit& u) const {
        const long L = (long)i * G + c; if (L >= nwg) return false;
        int wgid = (int)L; { const int q = nwg / NXCD, r = nwg % NXCD, xcd = wgid % NXCD, off = wgid / NXCD; wgid = (xcd < r ? xcd * (q + 1) : r * (q + 1) + (xcd - r) * q) + off; }
        const int nig = wgm * nN, gid = wgid / nig, fm = gid * wgm, gsz = (nM - fm) < wgm ? (nM - fm) : wgm;
        u.pm = fm + ((wgid % nig) % gsz); u.pn = (wgid % nig) / gsz; return true;
    }
    __device__ __forceinline__ void a_ready(const Unit&) const {}
    __device__ __forceinline__ void done(const Unit&) const {}
};

__device__ __forceinline__ unsigned cvt_pk_bf16(float lo, float hi) { unsigned r; asm volatile("v_cvt_pk_bf16_f32 %0, %1, %2" : "=v"(r) : "v"(lo), "v"(hi)); return r; }
typedef float f32x2 __attribute__((ext_vector_type(2)));
__device__ __forceinline__ f32x2 gelu_pk(f32x2 v) {
    const f32x2 av = __builtin_elementwise_abs(v), d = av * 0.2316418882f + 1.0f;
    f32x2 t; t.x = __builtin_amdgcn_rcpf(d.x); t.y = __builtin_amdgcn_rcpf(d.y);
    f32x2 q = t * 0.5307027145f + (-0.7265760135f); q = q * t + 0.7107068705f; q = q * t + (-0.142248368f); q = q * t + 0.127414796f; q = q * t;
    const f32x2 s = (v * v) * (-0.72134752044f);
    f32x2 e; e.x = __builtin_amdgcn_exp2f(s.x); e.y = __builtin_amdgcn_exp2f(s.y);
    const f32x2 m = v * (q * e), r = v - m;
    f32x2 o; o.x = v.x < 0.f ? m.x : r.x; o.y = v.y < 0.f ? m.y : r.y; return o;
}

template <int ACT  > struct EpiBf16 {
    static constexpr bool PERM = true, AFTER_DRAIN = false; static constexpr int MID_T = 0; static constexpr bool BLOCKED = false; static_assert(ACT == 0 || ACT == 1, "EpiBf16: ACT is 0 (none) or 1 (gelu_pk)");
    bf16_t* O; int ldc; const float* bias; int split_cols; size_t split_stride; float scale0;
    __device__ __forceinline__ void operator()(const f32x4 (&acc)[2][2][4][2], const Unit& u, int wr, int wc, int fr, int fq) const {
        const int row0 = u.pm * BM + wr * 64 + fr; int colt = u.pn * BM; bf16_t* base = O;
        float sc = 1.f; if (split_cols) { const int t = colt / split_cols; base += (size_t)t * split_stride; colt -= t * split_cols; if (t == 0) sc = scale0; }
        const int col0 = colt + wc * 32 + 8 * fq, bcol0 = u.pn * BM + wc * 32 + 8 * fq;
        f32x4 bv[2][2];
#pragma unroll
        for (int bj = 0; bj < 2; ++bj)
#pragma unroll
            for (int n = 0; n < 2; ++n) bv[bj][n] = bias ? *(const f32x4*)(bias + bcol0 + bj * HALF + 4 * n) : (f32x4){0.f, 0.f, 0.f, 0.f};
#pragma unroll
        for (int ai = 0; ai < 2; ++ai)
#pragma unroll
            for (int m = 0; m < 4; ++m) { bf16_t* rowp = base + (size_t)(row0 + ai * HALF + m * 16) * ldc + col0;
#pragma unroll
                for (int bj = 0; bj < 2; ++bj) { f32x4 v0 = acc[ai][bj][m][0] + bv[bj][0], v1 = acc[ai][bj][m][1] + bv[bj][1];
                    if (ACT == 1) { f32x2 a = gelu_pk((f32x2){v0[0], v0[1]}), b = gelu_pk((f32x2){v0[2], v0[3]}), c = gelu_pk((f32x2){v1[0], v1[1]}), d = gelu_pk((f32x2){v1[2], v1[3]});
                        v0 = (f32x4){a.x, a.y, b.x, b.y}; v1 = (f32x4){c.x, c.y, d.x, d.y}; }
                    v0 = v0 * sc; v1 = v1 * sc; u32x4 w; w.x = cvt_pk_bf16(v0[0], v0[1]); w.y = cvt_pk_bf16(v0[2], v0[3]); w.z = cvt_pk_bf16(v1[0], v1[1]); w.w = cvt_pk_bf16(v1[2], v1[3]);
                    *(u32x4*)(rowp + bj * HALF) = w; } }
    }
};


template <class Epi, class Sched, bool ALIGN_EPI = false, bool SP2 = false>
__device__ __forceinline__ void gemm_phase(PG8_LAS unsigned char* lds, const Gemm g, const Sched& S, const Epi& E, const int wave_id) {
    int tid_ = lane_here() + 64 * wave_id; asm volatile("" : "+v"(tid_));
    const int tid = tid_, wid = __builtin_amdgcn_readfirstlane(tid >> 6), lane = tid & 63, wr = wid >> 2, wc = wid & 3, fr = lane & 15, fq = lane >> 4;
    const int K = g.K, nt = K / BK;
    unsigned voffA[2], voffB[2];
#pragma unroll
    for (int i = 0; i < 2; ++i) { int R, C; stage_rc(tid * 16 + i * 8192, R, C); const int Rb = Epi::PERM ? ((R & ~31) + perm32(R & 31)) : R;
        (void)R; (void)C; (void)Rb; voffA[i] = (unsigned)(tid * 16 + i * 8192); voffB[i] = voffA[i]; }
    const unsigned kstep = (unsigned)(HALF * BK * 2);
    const unsigned hstep = (unsigned)HALF * (unsigned)K * 2u;
    const unsigned tstep = 2u * hstep;
    const unsigned ldsw = (unsigned)wid * 1024u;
    const int aoff = lds_byte(wr * 64 + fr, fq * 8), boff = lds_byte(wc * 32 + fr, fq * 8);
#define PG8_SA(b, h) (((b) * 2 + (h)) * HTB)
#define PG8_SB(b, h) ((4 + (b) * 2 + (h)) * HTB)
    const __amdgpu_buffer_rsrc_t srdA = __builtin_amdgcn_make_buffer_rsrc((void*)g.A, (short)0, (int)((size_t)g.M * (size_t)K * 2), 0x00020000);
    const __amdgpu_buffer_rsrc_t srdB = __builtin_amdgcn_make_buffer_rsrc((void*)g.Bt, (short)0, (int)((size_t)g.N * (size_t)K * 2), 0x00020000);
    const unsigned ldsb = __builtin_amdgcn_readfirstlane((unsigned)(__UINTPTR_TYPE__)lds);
#define PG8_STAGEX(srd, bufoff, off32, voff) do { _Pragma("unroll") for (int _i = 0; _i < 2; ++_i) { const unsigned m0_ = ldsb + (unsigned)(bufoff) + ldsw + (unsigned)(_i * 8192); const unsigned so_ = (unsigned)(off32); \
        asm volatile("s_mov_b32 m0, %0\n\ts_nop 0\n\tbuffer_load_dwordx4 %1, %2, %3 offen lds" :: "s"(m0_), "v"((voff)[_i]), "s"(srd), "s"(so_) : "m0", "memory"); } } while (0)
#define PG8_STAGEA(bufoff, off32, voff) PG8_STAGEX(srdA, bufoff, off32, voff)
#define PG8_STAGEB(bufoff, off32, voff) PG8_STAGEX(srdB, bufoff, off32, voff)
#define PG8_LDA(dst, b, h) do { _Pragma("unroll") for (int m = 0; m < 4; ++m) _Pragma("unroll") for (int k = 0; k < 2; ++k) dst[m][k] = *(const PG8_LAS bf16x8*)(lds + PG8_SA(b, h) + aoff + m * 2048 + k * 1024); } while (0)
#define PG8_LDB(dst, b, h) do { _Pragma("unroll") for (int n = 0; n < 2; ++n) _Pragma("unroll") for (int k = 0; k < 2; ++k) dst[n][k] = *(const PG8_LAS bf16x8*)(lds + PG8_SB(b, h) + boff + n * 2048 + k * 1024); } while (0)
#define PG8_MMA(ai, bj, At, Bt) do { __builtin_amdgcn_s_setprio(1); _Pragma("unroll") for (int m = 0; m < 4; ++m) _Pragma("unroll") for (int n = 0; n < 2; ++n) _Pragma("unroll") for (int k = 0; k < 2; ++k) \
        acc[ai][bj][m][n] = __builtin_amdgcn_mfma_f32_16x16x32_bf16(Bt[n][k], At[m][k], acc[ai][bj][m][n], 0, 0, 0); __builtin_amdgcn_s_setprio(0); } while (0)
#define PG8_WAIT_V(n) asm volatile("s_waitcnt vmcnt(" #n ")" ::: "memory")
#define PG8_WAIT_L(n) asm volatile("s_waitcnt lgkmcnt(" #n ")" ::: "memory")
#define PG8_BAR __builtin_amdgcn_s_barrier()
#define PG8_SCHED __builtin_amdgcn_sched_barrier(0)
    Unit cur, nxt; int ui = 0;
    if (!S.next(0, cur)) return;
    f32x4 acc[2][2][4][2];
#pragma unroll
    for (int a = 0; a < 2; ++a)
#pragma unroll
        for (int b = 0; b < 2; ++b)
#pragma unroll
            for (int m = 0; m < 4; ++m)
#pragma unroll
                for (int n = 0; n < 2; ++n) acc[a][b][m][n] = (f32x4){0.f, 0.f, 0.f, 0.f};
    bf16x8 At[4][2], B0[2][2], B1[2][2];
    unsigned cA = (unsigned)cur.pm * tstep, cB = (unsigned)cur.pn * tstep;
    S.a_ready(cur);
    if constexpr (SP2) {
        PG8_STAGEB(PG8_SB(0, 0), cB, voffB); PG8_STAGEB(PG8_SB(0, 1), cB + hstep, voffB); PG8_STAGEA(PG8_SA(0, 0), cA, voffA); PG8_STAGEA(PG8_SA(0, 1), cA + hstep, voffA);
        if (wr == 1) PG8_BAR;
        PG8_WAIT_V(2); PG8_BAR;
        PG8_STAGEB(PG8_SB(1, 0), cB + kstep, voffB); PG8_STAGEA(PG8_SA(1, 0), cA + kstep, voffA); PG8_STAGEB(PG8_SB(1, 1), cB + hstep + kstep, voffB);
        PG8_WAIT_V(6); PG8_BAR;
    } else {
        PG8_STAGEB(PG8_SB(0, 0), cB, voffB); PG8_STAGEA(PG8_SA(0, 0), cA, voffA); PG8_STAGEB(PG8_SB(0, 1), cB + hstep, voffB); PG8_STAGEA(PG8_SA(0, 1), cA + hstep, voffA);
        if (wr == 1) PG8_BAR;
        PG8_WAIT_V(4); PG8_BAR;
        PG8_STAGEB(PG8_SB(1, 0), cB + kstep, voffB); PG8_STAGEA(PG8_SA(1, 0), cA + kstep, voffA); PG8_STAGEB(PG8_SB(1, 1), cB + hstep + kstep, voffB);
        PG8_WAIT_V(6); PG8_BAR;
    }
    for (;;) {
        const bool has_next = S.next(ui + 1, nxt);
        const unsigned nA = has_next ? (unsigned)nxt.pm * tstep : cA, nB = has_next ? (unsigned)nxt.pn * tstep : cB;
        for (int t = 0; t < nt; t += 2) {
            if constexpr (Epi::MID_T > 0) { if (t == Epi::MID_T) E.mid(acc, cur, wr, wc, fr, fq); }
            const bool last = (t == nt - 2);
            const unsigned a1 = cA + (unsigned)(t + 1) * kstep;
            const unsigned a2 = last ? nA : cA + (unsigned)(t + 2) * kstep, b2 = last ? nB : cB + (unsigned)(t + 2) * kstep;
            const unsigned a3 = a2 + kstep, b3 = b2 + kstep;
            if (last && has_next) S.a_ready(nxt);
            if constexpr (SP2) {
            PG8_LDB(B0, 0, 0); PG8_LDB(B1, 0, 1); PG8_SCHED; PG8_LDA(At, 0, 0); PG8_STAGEA(PG8_SA(1, 1), a1 + hstep, voffA);
            PG8_WAIT_V(8); PG8_WAIT_L(0); PG8_BAR; PG8_MMA(0, 0, At, B0); PG8_MMA(0, 1, At, B1); PG8_BAR; PG8_SCHED;
            PG8_LDA(At, 0, 1); PG8_STAGEB(PG8_SB(0, 0), b2, voffB); PG8_STAGEB(PG8_SB(0, 1), b2 + hstep, voffB); PG8_STAGEA(PG8_SA(0, 0), a2, voffA);
            PG8_WAIT_V(8); PG8_WAIT_L(0); PG8_BAR; PG8_MMA(1, 0, At, B0); PG8_MMA(1, 1, At, B1); PG8_BAR; PG8_SCHED;
            PG8_LDB(B0, 1, 0); PG8_LDB(B1, 1, 1); PG8_SCHED; PG8_LDA(At, 1, 0); PG8_STAGEA(PG8_SA(0, 1), a2 + hstep, voffA);
            PG8_WAIT_V(8); PG8_WAIT_L(0); PG8_BAR; PG8_MMA(0, 0, At, B0); PG8_MMA(0, 1, At, B1); PG8_BAR; PG8_SCHED;
            PG8_LDA(At, 1, 1); PG8_STAGEB(PG8_SB(1, 0), b3, voffB); PG8_STAGEB(PG8_SB(1, 1), b3 + hstep, voffB); PG8_STAGEA(PG8_SA(1, 0), a3, voffA);
            PG8_WAIT_V(8); PG8_WAIT_L(0); PG8_BAR; PG8_MMA(1, 0, At, B0); PG8_MMA(1, 1, At, B1); PG8_BAR; PG8_SCHED;
            } else {
            PG8_LDB(B0, 0, 0); PG8_SCHED; PG8_LDA(At, 0, 0); PG8_STAGEA(PG8_SA(1, 1), a1 + hstep, voffA);
            PG8_WAIT_L(8); PG8_BAR; PG8_WAIT_L(0); PG8_MMA(0, 0, At, B0); PG8_BAR; PG8_SCHED;
            PG8_LDB(B1, 0, 1); PG8_STAGEB(PG8_SB(0, 0), b2, voffB);
            PG8_BAR; PG8_WAIT_L(0); PG8_MMA(0, 1, At, B1); PG8_BAR;
            PG8_LDA(At, 0, 1); PG8_STAGEA(PG8_SA(0, 0), a2, voffA);
            PG8_BAR; PG8_WAIT_L(0); PG8_MMA(1, 0, At, B0); PG8_BAR; PG8_SCHED;
            PG8_STAGEB(PG8_SB(0, 1), b2 + hstep, voffB);
            PG8_WAIT_V(6); PG8_BAR; PG8_MMA(1, 1, At, B1); PG8_BAR;
            PG8_LDB(B0, 1, 0); PG8_SCHED; PG8_LDA(At, 1, 0); PG8_STAGEA(PG8_SA(0, 1), a2 + hstep, voffA);
            PG8_WAIT_L(8); PG8_BAR; PG8_WAIT_L(0); PG8_MMA(0, 0, At, B0); PG8_BAR; PG8_SCHED;
            PG8_LDB(B1, 1, 1); PG8_STAGEB(PG8_SB(1, 0), b3, voffB);
            PG8_BAR; PG8_WAIT_L(0); PG8_MMA(0, 1, At, B1); PG8_BAR;
            PG8_LDA(At, 1, 1); PG8_STAGEA(PG8_SA(1, 0), a3, voffA);
            PG8_BAR; PG8_WAIT_L(0); PG8_MMA(1, 0, At, B0); PG8_BAR; PG8_SCHED;
            PG8_STAGEB(PG8_SB(1, 1), b3 + hstep, voffB);
            PG8_WAIT_V(6); PG8_BAR; PG8_MMA(1, 1, At, B1); PG8_BAR;
            }
        }
        if constexpr (ALIGN_EPI) { if (wr == 0) PG8_BAR; }
        if constexpr (!Epi::AFTER_DRAIN) { E(acc, cur, wr, wc, fr, fq); S.done(cur); }
        if (!has_next) break;
#pragma unroll
        for (int a = 0; a < 2; ++a)
#pragma unroll
            for (int b = 0; b < 2; ++b)
#pragma unroll
                for (int m = 0; m < 4; ++m)
#pragma unroll
                    for (int n = 0; n < 2; ++n) acc[a][b][m][n] = (f32x4){0.f, 0.f, 0.f, 0.f};
        cur = nxt; cA = nA; cB = nB; ++ui;
        if constexpr (ALIGN_EPI) { if (wr == 1) PG8_BAR; }
    }
    PG8_WAIT_V(0);
    if constexpr (!ALIGN_EPI) { if (wr == 0) PG8_BAR; }
    PG8_BAR;
    if constexpr (Epi::AFTER_DRAIN) { E.fused(acc, cur, wr, wc, fr, fq, lds, wid, lane); S.done(cur); }
#undef PG8_SA
#undef PG8_SB
#undef PG8_STAGEX
#undef PG8_STAGEA
#undef PG8_STAGEB
#undef PG8_LDA
#undef PG8_LDB
#undef PG8_MMA
#undef PG8_WAIT_V
#undef PG8_WAIT_L
#undef PG8_BAR
#undef PG8_SCHED
}
}

#define GAS __attribute__((address_space(1)))
#define LAS __attribute__((address_space(3)))
typedef unsigned short bf16;
typedef unsigned v4u __attribute__((ext_vector_type(4)));
typedef float f32x4 __attribute__((ext_vector_type(4)));
typedef short bf16x8 __attribute__((ext_vector_type(8)));
typedef GAS unsigned gu32;
typedef GAS unsigned long long gu64;
#define RLX_AGENT __ATOMIC_RELAXED, __HIP_MEMORY_SCOPE_AGENT
#define LDS_WAIT() asm volatile("s_waitcnt lgkmcnt(0)" ::: "memory")
#define VM_WAIT() asm volatile("s_waitcnt vmcnt(0)" ::: "memory")
__device__ __forceinline__ unsigned long long rt() { return __builtin_amdgcn_s_memrealtime(); }
__device__ __forceinline__ unsigned f2bf(float f) { unsigned u = __builtin_bit_cast(unsigned, f); return (u + 0x7fffu + ((u >> 16) & 1u)) >> 16; }
__device__ __forceinline__ unsigned pk2(float lo, float hi) { return f2bf(lo) | (f2bf(hi) << 16); }

#define XB_TMO      128
#define XB_XCNT(j)  (256  + 64 * (j))
#define XB_XSUB(j)  (1280 + 64 * (j))
#define XB_XGEN(j)  (2304 + 64 * (j))
#define XB_TOP      3328
#define XB_TOPGEN   3392
#define XCD_BAR_WORDS 3456
#define XB_SPIN_CAP (1u << 18)

__device__ __forceinline__ unsigned xb_ld(unsigned* p)              { return __hip_atomic_load(p, __ATOMIC_RELAXED, __HIP_MEMORY_SCOPE_AGENT); }
__device__ __forceinline__ unsigned xb_add(unsigned* p, unsigned v) { return __hip_atomic_fetch_add(p, v, __ATOMIC_RELAXED, __HIP_MEMORY_SCOPE_AGENT); }
__device__ __forceinline__ unsigned xb_xcc_id() { return (unsigned)__builtin_amdgcn_s_getreg((3 << 11) | 20) & 0xFu; }
#define XB_SPIN(cond, bar) do { unsigned _sp = 0; while (cond) { __builtin_amdgcn_s_sleep(1); \
    if ((++_sp & 255u) == 0u) { if (xb_ld(&(bar)[XB_TMO])) break; if (_sp > XB_SPIN_CAP) { atomicAdd(&(bar)[XB_TMO], 1u); break; } } } } while (0)

struct XcdBarrier {
    unsigned* bar; unsigned x;
    volatile LAS unsigned* st;
};

__device__ __forceinline__ XcdBarrier xcd_barrier_post(unsigned* bar, volatile LAS unsigned* st) {
    XcdBarrier b; b.bar = bar; b.x = xb_xcc_id(); b.st = st;
    if (threadIdx.x == 0) (void)xb_add(&bar[XB_XCNT(b.x)], 1u);
    return b;
}
__device__ __forceinline__ void xcd_barrier_complete(unsigned* bar, unsigned x, unsigned& nloc, unsigned& nx) {
    const unsigned G = gridDim.x * gridDim.y * gridDim.z;
    unsigned sum, cnt, mine, sp = 0u;
    for (;;) {
        sum = 0u; cnt = 0u; mine = 0u;
#pragma unroll
        for (unsigned j = 0; j < 16; ++j) { const unsigned c = xb_ld(&bar[XB_XCNT(j)]); sum += c; cnt += (c > 0u) ? 1u : 0u; mine = (j == x) ? c : mine; }
        if (sum == G) break;
        __builtin_amdgcn_s_sleep(1);
        if ((++sp & 255u) == 0u) { if (xb_ld(&bar[XB_TMO])) break; if (sp > XB_SPIN_CAP) { atomicAdd(&bar[XB_TMO], 1u); break; } }
    }
    nloc = mine > 0u ? mine : 1u; nx = cnt > 0u ? cnt : 1u;
}

__device__ __forceinline__ void xcd_barrier(const XcdBarrier& b, const bool xb_wave0, const bool rel = true) {
    asm volatile("s_waitcnt vmcnt(0)" ::: "memory");
    __syncthreads();
    if (xb_wave0 && lane_here() == 0) {
        unsigned* bar = b.bar;
        __builtin_amdgcn_s_waitcnt(0);
        unsigned nloc = b.st[0], nx = b.st[1];
        if (nloc == 0u) { xcd_barrier_complete(bar, b.x, nloc, nx); b.st[0] = nloc; b.st[1] = nx; }
        const unsigned old = xb_add(&bar[XB_XSUB(b.x)], 1u);
        const unsigned gen = old / nloc;
        if (old + 1u == (gen + 1u) * nloc) {
            if (rel) __builtin_amdgcn_fence(__ATOMIC_RELEASE, "agent");
            asm volatile("s_waitcnt vmcnt(0)" ::: "memory");
            const unsigned og = xb_add(&bar[XB_TOP], 1u);
            const unsigned tg = og / nx;
            __builtin_amdgcn_fence(__ATOMIC_ACQUIRE, "agent");
            if (og + 1u == (tg + 1u) * nx) xb_add(&bar[XB_TOPGEN], 1u);
            else XB_SPIN(xb_ld(&bar[XB_TOPGEN]) == tg, bar);
            xb_add(&bar[XB_XGEN(b.x)], 1u);
            asm volatile("s_waitcnt vmcnt(0)" ::: "memory");
        } else {
            __builtin_amdgcn_fence(__ATOMIC_ACQUIRE, "agent");
            XB_SPIN(xb_ld(&bar[XB_XGEN(b.x)]) == gen, bar);
            asm volatile("s_waitcnt vmcnt(0)" ::: "memory");
        }
    }
    __syncthreads();
}


__device__ __forceinline__ void xcc_local_barrier(unsigned* ctr, volatile LAS unsigned* st, const unsigned nwg_cls, const bool xb_wave0) {
    asm volatile("s_waitcnt vmcnt(0)" ::: "memory");
    __syncthreads();
    if (xb_wave0 && lane_here() == 0) {
        const unsigned k = st[0] + 1u;
        (void)xb_add(ctr, 1u);
        __builtin_amdgcn_fence(__ATOMIC_ACQUIRE, "agent");
        { unsigned sp = 0u; while (xb_ld(ctr) < k * nwg_cls) { __builtin_amdgcn_s_sleep(1); if (++sp > (1u << 22)) break; } }
        asm volatile("s_waitcnt vmcnt(0)" ::: "memory");
        st[0] = k;
    }
    __syncthreads();
}

constexpr int NWAVES = 8;
#ifndef MK_ONE_LAUNCH
#define MK_ONE_LAUNCH 1
#endif
constexpr int BATCH = 2, SEQ = 8192, M = BATCH * SEQ, DM = 2048, DEPTH = 4;
constexpr int NQH = 16, NKVH = 4, HD = 64, AW = 1024, KVW = 256, WIN = 128;
constexpr int SGUW = 1024, SGUG = 8, CHUNK = 128, DFF = 5632;
constexpr int OFF_Q = 0, OFF_K = 1024, OFF_V = 1280, OFF_Z = 1536, OFF_G = 3584, INW = 7680;
constexpr float EPS = 1e-5f;

constexpr size_t MiB = 1u << 20;
constexpr size_t WS_CTL = 0, CTL_ZERO_BYTES = 4 * MiB;
constexpr size_t WS_SSQ = 1 * MiB;
constexpr size_t WS_ZST = 2 * MiB + 512 * 1024;
constexpr size_t WS_CS = 4 * MiB;
constexpr size_t WS_W = 8 * MiB, W_LAYER = 112 * MiB;
constexpr size_t WL_IN = 0, WL_AB = 30 * MiB, WL_SB = 34 * MiB, WL_OUT = 38 * MiB, WL_GU = 46 * MiB, WL_DN = 90 * MiB;
constexpr size_t WS_HB = WS_W + DEPTH * W_LAYER;
constexpr size_t WS_Q = WS_HB + 64 * MiB, WS_K = WS_Q + 32 * MiB, WS_V = WS_K + 8 * MiB;
constexpr size_t WS_Z = WS_V + 8 * MiB;
constexpr size_t WS_G = WS_Z + 64 * MiB;
constexpr size_t WS_Y = WS_G + 128 * MiB;
constexpr size_t WS_MG = WS_Y + 64 * MiB;
constexpr size_t WS_ACT = WS_MG + 64 * MiB;
constexpr size_t WS_T = WS_ACT;
constexpr size_t WS_END = WS_ACT + 176 * MiB;
static_assert((size_t)INW * DM * 2 <= 30 * MiB && (size_t)2 * DM * DFF * 2 <= 44 * MiB && (size_t)DM * DFF * 2 <= 22 * MiB, "weight map");
static_assert((size_t)M * DFF * 2 <= 176 * MiB && (size_t)M * DM * 4 <= 176 * MiB, "act map");
constexpr int CW_BAR = 4096, CW_XTAB = 16384, CW_XL = 20480;
constexpr size_t WS_SGUWM = 5 * MiB;
constexpr int P2_KROW = 144, P2_VROW = 528, P2_SROW = 272, P2_K = 0, P2_V = 256 * P2_KROW, P2_LN = 72 * 1024, P2_WM = 76 * 1024;

constexpr int RING_BYTES = 131072, LDS_BYTES = 147456, LDSCTL_OFF = LDS_BYTES - 1024, MISC_OFF = LDSCTL_OFF + 320;

typedef unsigned v2u __attribute__((ext_vector_type(2)));
typedef float f32x2 __attribute__((ext_vector_type(2)));
__device__ __forceinline__ float bf2f(unsigned h) { return __builtin_bit_cast(float, h << 16); }
__device__ __forceinline__ float bflo(unsigned w) { return __builtin_bit_cast(float, w << 16); }
__device__ __forceinline__ float bfhi(unsigned w) { return __builtin_bit_cast(float, w & 0xffff0000u); }
__device__ __forceinline__ float wave_sum(float v) {
#pragma unroll
    for (int o = 1; o < 64; o <<= 1) v += __shfl_xor(v, o);
    return v;
}
__device__ __forceinline__ float wave_max(float v) {
#pragma unroll
    for (int o = 1; o < 64; o <<= 1) v = fmaxf(v, __shfl_xor(v, o));
    return v;
}
constexpr double FX_SSQ = 1048576.0, FX_ZST = 4294967296.0;
__device__ __forceinline__ unsigned long long fx_enc(float v, double scale) { return (unsigned long long)(long long)((double)v * scale); }
__device__ __forceinline__ void fx_add(unsigned long long* p, float v, double scale) { __hip_atomic_fetch_add(p, fx_enc(v, scale), __ATOMIC_RELAXED, __HIP_MEMORY_SCOPE_AGENT); }
__device__ __forceinline__ float rstd_from_ssq(const unsigned long long* p) { const unsigned long long v = *p; const float f = (float)(unsigned)(v >> 32) * 4294967296.0f + (float)(unsigned)v;
    return __builtin_amdgcn_rsqf(f * (float)(1.0 / (FX_SSQ * 2048.0)) + 1e-5f); }
__device__ __forceinline__ float sigmoidf_(float x) { return __builtin_amdgcn_rcpf(1.0f + __builtin_amdgcn_exp2f(-1.4426950408889634f * x)); }

__device__ __forceinline__ size_t blk_idx(size_t r, int c, int cols) { return ((r >> 7) * (size_t)(cols >> 6) + (size_t)(c >> 6)) * 8192 + (size_t)(pg8::lds_byte((int)(r & 127), c & 63) >> 1); }
__device__ __forceinline__ unsigned epi_img_byte(int wr, int wc, int fr, int fq) { return (unsigned)((wc >> 1) * 16384 + (8 * wr + (wc & 1)) * 1024 + ((fr * 64 + 16 * fq) ^ ((fr >> 3) << 5))); }
struct rsrc_t { const char* p; };
__device__ __forceinline__ rsrc_t mk_rsrc(const void* p, size_t) { rsrc_t r; r.p = (const char*)p; return r; }
__device__ __forceinline__ v4u bld16(rsrc_t r, unsigned voff, unsigned soff) { const char* sb = r.p + soff; asm volatile("" : "+s"(sb)); return *(const GAS v4u*)((const GAS char*)sb + voff); }
__device__ __forceinline__ v2u bld8(rsrc_t r, unsigned voff, unsigned soff) { const char* sb = r.p + soff; asm volatile("" : "+s"(sb)); return *(const GAS v2u*)((const GAS char*)sb + voff); }
__device__ __forceinline__ void bst16nt(v4u v, rsrc_t r, unsigned voff, unsigned soff) { const char* sb = r.p + soff; asm volatile("" : "+s"(sb)); __builtin_nontemporal_store(v, (GAS v4u*)((GAS char*)sb + voff)); }
__device__ __forceinline__ void bst16(v4u v, rsrc_t r, unsigned voff, unsigned soff) { const char* sb = r.p + soff; asm volatile("" : "+s"(sb)); *(GAS v4u*)((GAS char*)sb + voff) = v; }
__device__ __forceinline__ float rstd_from_bits(v2u w) { const float f = (float)w.y * 4294967296.0f + (float)w.x; return __builtin_amdgcn_rsqf(f * (float)(1.0 / (FX_SSQ * 2048.0)) + 1e-5f); }
namespace pg8 {
typedef __bf16 bf16x2_t __attribute__((ext_vector_type(2)));
__device__ __forceinline__ unsigned cvtpk(float lo, float hi) { const f32x2 v = {lo, hi}; return __builtin_bit_cast(unsigned, __builtin_convertvector(v, bf16x2_t)); }
__device__ __forceinline__ v4u pack8(const f32x4 v0, const f32x4 v1) { v4u w; w.x = cvtpk(v0[0], v0[1]); w.y = cvtpk(v0[2], v0[3]); w.z = cvtpk(v1[0], v1[1]); w.w = cvtpk(v1[2], v1[3]); return w; }
#define PIN2(a, b) asm volatile("" : "+v"(a), "+v"(b))
__device__ __forceinline__ f32x4 unlo(const v4u w) { return (f32x4){bflo(w.x), bfhi(w.x), bflo(w.y), bfhi(w.y)}; }
__device__ __forceinline__ f32x4 unhi(const v4u w) { return (f32x4){bflo(w.z), bfhi(w.z), bflo(w.w), bfhi(w.w)}; }
struct EpiInProj {
    static constexpr bool PERM = true, AFTER_DRAIN = false; static constexpr int MID_T = 0; static constexpr bool BLOCKED = false;
    const unsigned long long* ssq; const float* bias; const float* cs; unsigned long long* zst; bf16_t *q, *k, *v, *z, *g;
    __device__ __forceinline__ void operator()(const f32x4 (&acc)[2][2][4][2], const Unit& u, int wr, int wc, int fr, int fq) const {
        const int colt = u.pn * BM;
        bf16_t* base; int ldc, cb, mode;
        if (colt < OFF_K) { base = q; ldc = AW; cb = colt; mode = 0; }
        else if (colt < OFF_V) { base = k; ldc = KVW; cb = colt - OFF_K; mode = 0; }
        else if (colt < OFF_Z) { base = v; ldc = KVW; cb = colt - OFF_V; mode = 0; }
        else if (colt < OFF_G) { base = z; ldc = 2 * SGUW; cb = colt - OFF_Z; mode = 1; }
        else { base = g; ldc = DM; cb = (colt - OFF_G) >> 1; mode = 2; }
        const bool rope = (colt < OFF_V) && ((wc & 1) == 0);
        const bool vstat = (mode == 1) && (cb >= SGUW);
        const rsrc_t ro = mk_rsrc(base, (size_t)M * ldc * (mode == 2 ? 4 : 2)), rq = mk_rsrc(ssq, (size_t)M * 8), rc = mk_rsrc(cs, (size_t)M * 64);
        const unsigned lrow = wr * 64 + fr, vo = (lrow * ldc + wc * 32 + 8 * fq) * 2u, vq = lrow * 8u, vc = lrow * 64u;
        const unsigned so = ((unsigned)u.pm * BM * ldc + cb) * 2u, sq = (unsigned)u.pm * BM * 8u, sc = (unsigned)u.pm * BM * 64u;
        const int bcol0 = (mode == 2 ? OFF_G + cb : colt) + wc * 32 + 8 * fq;
        f32x4 bv[2][2];
#pragma unroll
        for (int bj = 0; bj < 2; ++bj)
#pragma unroll
            for (int n = 0; n < 2; ++n) bv[bj][n] = *(const f32x4*)(bias + bcol0 + bj * (mode == 2 ? DM : HALF) + 4 * n);
        v2u sw[2][4];
#pragma unroll
        for (int ai = 0; ai < 2; ++ai)
#pragma unroll
            for (int m = 0; m < 4; ++m) sw[ai][m] = bld8(rq, vq, sq + (ai * HALF + m * 16) * 8u);
#pragma unroll
        for (int ai = 0; ai < 2; ++ai)
#pragma unroll
            for (int m = 0; m < 4; ++m) { const unsigned rofs = (ai * HALF + m * 16); const float rs = rstd_from_bits(sw[ai][m]);
                if (mode == 2) {
                    const float c1 = rs * -1.4426950408889634f; f32x4 rv[2], sv[2];
#pragma unroll
                    for (int n = 0; n < 2; ++n) {
                        f32x4 ea = acc[ai][0][m][n] * c1 + bv[0][n] * -1.4426950408889634f, eb = acc[ai][1][m][n] * c1 + bv[1][n] * -1.4426950408889634f;
#pragma unroll
                        for (int j = 0; j < 4; ++j) { ea[j] = fminf(ea[j], 80.f); eb[j] = fminf(eb[j], 80.f); }
                        PIN2(ea, eb);
#pragma unroll
                        for (int j = 0; j < 4; ++j) { ea[j] = __builtin_amdgcn_exp2f(ea[j]); eb[j] = __builtin_amdgcn_exp2f(eb[j]); }
                        ea += 1.0f; eb += 1.0f; PIN2(ea, eb);
                        f32x4 ra, rb;
#pragma unroll
                        for (int j = 0; j < 4; ++j) { ra[j] = __builtin_amdgcn_rcpf(ea[j]); rb[j] = __builtin_amdgcn_rcpf(eb[j]); }
                        PIN2(ra, rb);
                        rv[n] = eb * ra; sv[n] = rb; }
                    {
                        const unsigned vg = (unsigned)(((wr * 4 + wc) * 64 + fq * 16 + fr) * 16), sg = ((((unsigned)u.pm * 16u + (unsigned)(cb >> 7)) * 2u + ai) * 4u + m) * 8192u;
                        bst16(pack8(rv[0], rv[1]), ro, vg, sg); bst16(pack8(sv[0], sv[1]), ro, vg, sg + (unsigned)((size_t)M * DM * 2)); }
                    continue; }
                f32x4 c0, c1, s0, s1;
                if (rope) { c0 = __builtin_bit_cast(f32x4, bld16(rc, vc, sc + rofs * 64u)); c1 = __builtin_bit_cast(f32x4, bld16(rc, vc, sc + rofs * 64u + 16u)); s0 = __builtin_bit_cast(f32x4, bld16(rc, vc, sc + rofs * 64u + 32u)); s1 = __builtin_bit_cast(f32x4, bld16(rc, vc, sc + rofs * 64u + 48u));
                    if (fq == 0) { s0 = -s0; s1 = -s1; } }
                float z1 = 0.f, z2 = 0.f;
#pragma unroll
                for (int bj = 0; bj < 2; ++bj) { f32x4 v0 = acc[ai][bj][m][0] * rs + bv[bj][0], v1 = acc[ai][bj][m][1] * rs + bv[bj][1];
                    if (rope) { f32x4 p0, p1;
#pragma unroll
                        for (int j = 0; j < 4; ++j) { p0[j] = __shfl_xor(v0[j], 16); p1[j] = __shfl_xor(v1[j], 16); }
                        if (fq < 2) { v0 = v0 * c0 + p0 * s0; v1 = v1 * c1 + p1 * s1; } }
                    if (mode == 1) { f32x2 a = gelu_pk((f32x2){v0[0], v0[1]}), b = gelu_pk((f32x2){v0[2], v0[3]}), c = gelu_pk((f32x2){v1[0], v1[1]}), d = gelu_pk((f32x2){v1[2], v1[3]});
                        v0 = (f32x4){a.x, a.y, b.x, b.y}; v1 = (f32x4){c.x, c.y, d.x, d.y};
                        if (vstat) { z1 += (v0[0] + v0[1]) + (v0[2] + v0[3]) + (v1[0] + v1[1]) + (v1[2] + v1[3]);
                            z2 += (v0[0] * v0[0] + v0[1] * v0[1]) + (v0[2] * v0[2] + v0[3] * v0[3]) + (v1[0] * v1[0] + v1[1] * v1[1]) + (v1[2] * v1[2] + v1[3] * v1[3]); } }
                    bst16(pack8(v0, v1), ro, vo, so + (rofs * ldc + bj * HALF) * 2u); }
                if (vstat) { z1 += __shfl_xor(z1, 16); z1 += __shfl_xor(z1, 32); z2 += __shfl_xor(z2, 16); z2 += __shfl_xor(z2, 32);
                    const size_t r = (size_t)u.pm * BM + lrow + rofs;
                    if (fq == 0) { fx_add(zst + r * 2, z1, FX_ZST); fx_add(zst + r * 2 + 1, z2, FX_ZST); } } }
    }
};
struct EpiGate {
    static constexpr bool PERM = true, AFTER_DRAIN = false; static constexpr int MID_T = AW / BK; static constexpr bool BLOCKED = false;
    const bf16_t* gr; const bf16_t* gs; bf16_t* mg;
    __device__ __forceinline__ void mid(f32x4 (&acc)[2][2][4][2], const Unit& u, int wr, int wc, int fr, int fq) const {
        const rsrc_t rg = mk_rsrc(gr, (size_t)M * DM * 2);
        const unsigned vg = (unsigned)(((wr * 4 + wc) * 64 + fq * 16 + fr) * 16);
        const unsigned vo = ((wr * 64 + fr) * DM + wc * 32 + 8 * fq) * 2u, so = ((unsigned)u.pm * BM * DM + (unsigned)u.pn * BM) * 2u;
#pragma unroll
        for (int ai = 0; ai < 2; ++ai) { v4u gw[4][2];
#pragma unroll
            for (int m = 0; m < 4; ++m)
#pragma unroll
                for (int bj = 0; bj < 2; ++bj) gw[m][bj] = bld16(rg, vg, ((((unsigned)u.pm * 16u + 2u * (unsigned)u.pn + bj) * 2u + ai) * 4u + m) * 8192u);
#pragma unroll
            for (int m = 0; m < 4; ++m)
#pragma unroll
                for (int bj = 0; bj < 2; ++bj) { acc[ai][bj][m][0] *= unlo(gw[m][bj]); acc[ai][bj][m][1] *= unhi(gw[m][bj]); } }
    }
    __device__ __forceinline__ void operator()(const f32x4 (&acc)[2][2][4][2], const Unit& u, int wr, int wc, int fr, int fq) const {
        const rsrc_t rg = mk_rsrc(gs, (size_t)M * DM * 2), ro = mk_rsrc(mg, (size_t)M * DM * 2);
        const unsigned vg = (unsigned)(((wr * 4 + wc) * 64 + fq * 16 + fr) * 16);
        const unsigned vo = ((wr * 64 + fr) * DM + wc * 32 + 8 * fq) * 2u, so = ((unsigned)u.pm * BM * DM + (unsigned)u.pn * BM) * 2u;
        const unsigned vb_ = epi_img_byte(wr, wc, fr, fq) >> 1, sb_ = ((unsigned)u.pm * 2u * (DM / 64) + (unsigned)u.pn * 4u) * 8192u;
        v4u gw[2][4][2];
#pragma unroll
        for (int ai = 0; ai < 2; ++ai)
#pragma unroll
            for (int m = 0; m < 4; ++m)
#pragma unroll
                for (int bj = 0; bj < 2; ++bj) gw[ai][m][bj] = bld16(rg, vg, ((((unsigned)u.pm * 16u + 2u * (unsigned)u.pn + bj) * 2u + ai) * 4u + m) * 8192u);
#pragma unroll
        for (int ai = 0; ai < 2; ++ai)
#pragma unroll
            for (int m = 0; m < 4; ++m)
#pragma unroll
                for (int bj = 0; bj < 2; ++bj) bst16(pack8(acc[ai][bj][m][0] * unlo(gw[ai][m][bj]), acc[ai][bj][m][1] * unhi(gw[ai][m][bj])), ro, vb_ * 2u, (sb_ + ((unsigned)ai * (DM / 64) + 2u * bj) * 8192u + m * 1024u) * 2u);
    }
};
struct EpiResid {
    static constexpr bool PERM = true, AFTER_DRAIN = false; static constexpr int MID_T = 0; static constexpr bool BLOCKED = true;
    float* hout; bf16_t* hb; unsigned long long* ssq_out;
    __device__ __forceinline__ void operator()(const f32x4 (&acc)[2][2][4][2], const Unit& u, int wr, int wc, int fr, int fq) const {
        const rsrc_t rh = mk_rsrc(hout, 0), rb = mk_rsrc(hb, 0);
        const unsigned lrow = wr * 64 + fr, ve = lrow * DM + wc * 32 + 8 * fq, se = (unsigned)u.pm * BM * DM + (unsigned)u.pn * BM;
        const unsigned vb_ = epi_img_byte(wr, wc, fr, fq) >> 1, sb_ = ((unsigned)u.pm * 2u * (DM / 64) + (unsigned)u.pn * 4u) * 8192u;
        const bool out32 = hout != nullptr;
        v4u tb[2][4][2];
#pragma unroll
        for (int ai = 0; ai < 2; ++ai)
#pragma unroll
            for (int m = 0; m < 4; ++m)
#pragma unroll
                for (int bj = 0; bj < 2; ++bj) tb[ai][m][bj] = bld16(rb, vb_ * 2u, (sb_ + ((unsigned)ai * (DM / 64) + 2u * bj) * 8192u + m * 1024u) * 2u);
#pragma unroll
        for (int ai = 0; ai < 2; ++ai)
#pragma unroll
            for (int m = 0; m < 4; ++m) { float sq = 0.f;
#pragma unroll
                for (int bj = 0; bj < 2; ++bj) { const unsigned e = se + (ai * HALF + m * 16) * DM + bj * HALF, eb = sb_ + ((unsigned)ai * (DM / 64) + 2u * bj) * 8192u + m * 1024u;
                    const f32x4 v0 = acc[ai][bj][m][0] + unlo(tb[ai][m][bj]), v1 = acc[ai][bj][m][1] + unhi(tb[ai][m][bj]);
                    if (out32) { bst16(__builtin_bit_cast(v4u, v0), rh, ve * 4u, e * 4u); bst16(__builtin_bit_cast(v4u, v1), rh, ve * 4u, e * 4u + 16u); }
                    sq += (v0[0] * v0[0] + v0[1] * v0[1]) + (v0[2] * v0[2] + v0[3] * v0[3]) + (v1[0] * v1[0] + v1[1] * v1[1]) + (v1[2] * v1[2] + v1[3] * v1[3]);
                    bst16(pack8(v0, v1), rb, vb_ * 2u, eb * 2u); }
                sq += __shfl_xor(sq, 16); sq += __shfl_xor(sq, 32);
                if (fq == 0) fx_add(ssq_out + (size_t)u.pm * BM + lrow + ai * HALF + m * 16, sq, FX_SSQ); }
    }
};
struct EpiSwiglu {
    static constexpr bool PERM = true, AFTER_DRAIN = false; static constexpr int MID_T = 0; static constexpr bool BLOCKED = false;
    const unsigned long long* ssq; bf16_t* act;
    __device__ __forceinline__ void operator()(const f32x4 (&acc)[2][2][4][2], const Unit& u, int wr, int wc, int fr, int fq) const {
        const rsrc_t ro = mk_rsrc(act, (size_t)M * DFF * 2), rq = mk_rsrc(ssq, (size_t)M * 8);
        const unsigned lrow = wr * 64 + fr, vo = epi_img_byte(wr, wc, fr, fq), so = (((unsigned)u.pm * 2u * (DFF / 64) + (unsigned)u.pn * 2u) * 8192u) * 2u, vq = lrow * 8u, sq = (unsigned)u.pm * BM * 8u;
        v2u sw[2][4];
#pragma unroll
        for (int ai = 0; ai < 2; ++ai)
#pragma unroll
            for (int m = 0; m < 4; ++m) sw[ai][m] = bld8(rq, vq, sq + (ai * HALF + m * 16) * 8u);
#pragma unroll
        for (int ai = 0; ai < 2; ++ai)
#pragma unroll
            for (int m = 0; m < 4; ++m) { const float rs = rstd_from_bits(sw[ai][m]); const float c1 = rs * -1.4426950408889634f, rs2 = rs * rs;
                const f32x4 a0 = acc[ai][0][m][0], a1 = acc[ai][0][m][1];
                f32x4 e0 = a0 * c1, e1 = a1 * c1; PIN2(e0, e1);
#pragma unroll
                for (int j = 0; j < 4; ++j) { e0[j] = __builtin_amdgcn_exp2f(e0[j]); e1[j] = __builtin_amdgcn_exp2f(e1[j]); }
                f32x4 p0 = a0 * acc[ai][1][m][0], p1 = a1 * acc[ai][1][m][1]; p0 *= rs2; p1 *= rs2;
                e0 += 1.0f; e1 += 1.0f; PIN2(e0, e1);
#pragma unroll
                for (int j = 0; j < 4; ++j) { e0[j] = __builtin_amdgcn_rcpf(e0[j]); e1[j] = __builtin_amdgcn_rcpf(e1[j]); }
                PIN2(e0, e1);
                bst16nt(pack8(p0 * e0, p1 * e1), ro, vo, so + ((unsigned)ai * (DFF / 64) * 8192u + m * 16 * 64u) * 2u); }
    }
};
}

struct Frame {
    LAS unsigned char* lds; volatile LAS unsigned* MISC; gu32* ctl;
    int tid, lane, wave, vcu, G;
};
struct Args { const void* in[17]; float* out; unsigned char* ws; int ph_lo, ph_hi, li, pad; };
enum { I_X = 0, I_POS, I_N1G, I_WIN, I_BIN, I_SINKS, I_LNG, I_LNB, I_SGUW, I_SGUB, I_WAB, I_WSB, I_WOUT, I_N2G, I_WGU, I_WDN, I_FG };

constexpr int TP_PITCH = 272, TP_SCR_BYTES = 32 * TP_PITCH;
typedef short s16x4_t __attribute__((ext_vector_type(4)));
__device__ __forceinline__ void transpose_item(const float* W, int K, int N, bf16* WT, int ldk, int koff, const float* gain, int mode, LAS float* scr_, int item, int lane) {
    LAS unsigned char* scr = (LAS unsigned char*)scr_;
    const int nblk = N / 128, kb = item / nblk, nb = item % nblk, k0 = 32 * kb, n0 = 128 * nb;
    const int kr = lane >> 5, n4 = lane & 31;
    const float* src = W + (size_t)(k0 + kr) * N + n0 + 4 * n4;
    f32x4 v[16];
#pragma unroll
    for (int i = 0; i < 16; ++i) v[i] = __builtin_nontemporal_load((const f32x4*)(src + (size_t)(2 * i) * N));
    if (gain) {
#pragma unroll
        for (int i = 0; i < 16; ++i) v[i] *= gain[k0 + 2 * i + kr]; }
#pragma unroll
    for (int i = 0; i < 16; ++i) *(LAS v2u*)(scr + (2 * i + kr) * TP_PITCH + 8 * n4) = (v2u){pg8::cvtpk(v[i][0], v[i][1]), pg8::cvtpk(v[i][2], v[i][3])};
    LDS_WAIT(); asm volatile("" ::: "memory");
    int d0 = n0;
    if (mode == 1) { const int bj = n0 / DFF, rem = n0 % DFF; d0 = 256 * (rem / 128) + 128 * bj; }
    if (mode == 2 && n0 >= OFF_G) { const int rel = n0 - OFF_G, bj = rel / DM, rem = rel % DM; d0 = OFF_G + 256 * (rem / 128) + 128 * bj; }
    GAS unsigned char* dst = (GAS unsigned char*)(WT + ((size_t)(d0 >> 7) * (ldk / 64) + (koff + k0) / 64) * 8192) + (((koff + k0) >> 5) & 1) * 1024;
    const int fr = lane & 15, fq = lane >> 4, q = fr >> 2, p = fr & 3;
    const unsigned ob = (unsigned)((fr * 64 + fq * 16) ^ ((fr >> 3) << 5));
#pragma unroll
    for (int G = 0; G < 8; ++G) {
        const LAS unsigned char* tp = scr + (8 * fq + q) * TP_PITCH + (32 * (G >> 1) + 8 * p + 4 * (G & 1)) * 2;
        const s16x4_t lo = __builtin_amdgcn_ds_read_tr16_b64_v4i16((LAS s16x4_t*)tp), hi = __builtin_amdgcn_ds_read_tr16_b64_v4i16((LAS s16x4_t*)(tp + 4 * TP_PITCH));
        const v2u l2 = __builtin_bit_cast(v2u, lo), h2 = __builtin_bit_cast(v2u, hi);
        *(GAS v4u*)(dst + G * 2048 + ob) = (v4u){l2.x, l2.y, h2.x, h2.y}; }
    LDS_WAIT(); asm volatile("" ::: "memory");
}
__device__ __forceinline__ void sincos_red(float ang, float& c, float& s) {
    const double a = (double)ang; const double kq = __builtin_rint(a * 0.63661977236758134308);
    const double r = __builtin_fma(-kq, 1.57079632679489661923, a) - kq * 6.123233995736766e-17; const double r2 = r * r;
    double sp = -2.5052108385441718775e-8; sp = sp * r2 + 2.7557319223985890653e-6; sp = sp * r2 - 1.9841269841269841253e-4; sp = sp * r2 + 8.3333333333333332177e-3; sp = sp * r2 - 1.6666666666666665741e-1; sp = r + r * r2 * sp;
    double cp = 2.0876756987868098979e-9; cp = cp * r2 - 2.7557319223985890653e-7; cp = cp * r2 + 2.4801587301587301566e-5; cp = cp * r2 - 1.3888888888888889419e-3; cp = cp * r2 + 4.1666666666666664354e-2; cp = cp * r2 - 0.5; cp = 1.0 + r2 * cp;
    const int qd = ((int)(long long)kq) & 3;
    const double cs = (qd & 1) ? sp : cp, sn = (qd & 1) ? cp : sp;
    c = (float)((qd == 1 || qd == 2) ? -cs : cs); s = (float)((qd >= 2) ? -sn : sn);
}

constexpr int CI_IN = (DM / 64) * (INW / 64), CI_AB = (AW / 64) * (DM / 64), CI_SB = (SGUW / 64) * (DM / 64), CI_OUT = (DM / 64) * (DM / 64), CI_GU = (DM / 64) * (2 * DFF / 64), CI_DN = (DFF / 64) * (DM / 64);
constexpr int CI_LAYER = CI_IN + CI_AB + CI_SB + CI_OUT + CI_GU + CI_DN;
constexpr int CI_IDLE_PER_WAVE = 5;
__device__ __forceinline__ void convert_item(const Args& args, unsigned char* ws, int l, int r, LAS float* scr, int lane) {
    unsigned char* wl = ws + WS_W + (size_t)l * W_LAYER;
    const float* W; int K, N, ldk, koff = 0, mode = 0; bf16* WT; const float* gain = nullptr;
    if (r < CI_IN) { W = (const float*)args.in[I_WIN] + (size_t)l * DM * INW; K = DM; N = INW; WT = (bf16*)(wl + WL_IN); ldk = DM; gain = (const float*)args.in[I_N1G] + l * DM; mode = 2; }
    else if ((r -= CI_IN) < CI_AB) { W = (const float*)args.in[I_WAB] + (size_t)l * AW * DM; K = AW; N = DM; WT = (bf16*)(wl + WL_AB); ldk = DM; }
    else if ((r -= CI_AB) < CI_SB) { W = (const float*)args.in[I_WSB] + (size_t)l * SGUW * DM; K = SGUW; N = DM; WT = (bf16*)(wl + WL_AB); ldk = DM; koff = AW; }
    else if ((r -= CI_SB) < CI_OUT) { W = (const float*)args.in[I_WOUT] + (size_t)l * DM * DM; K = DM; N = DM; WT = (bf16*)(wl + WL_OUT); ldk = DM; }
    else if ((r -= CI_OUT) < CI_GU) { W = (const float*)args.in[I_WGU] + (size_t)l * DM * 2 * DFF; K = DM; N = 2 * DFF; WT = (bf16*)(wl + WL_GU); ldk = DM; gain = (const float*)args.in[I_N2G] + l * DM; mode = 1; }
    else { r -= CI_GU; W = (const float*)args.in[I_WDN] + (size_t)l * DFF * DM; K = DFF; N = DM; WT = (bf16*)(wl + WL_DN); ldk = DFF; }
    transpose_item(W, K, N, WT, ldk, koff, gain, mode, scr, r, lane);
}

constexpr int NPL = 6;
constexpr int N_PHASES = 1 + DEPTH * NPL + 1;

__global__ void __launch_bounds__(NWAVES * 64, 2) fwd(Args args) {
    extern __shared__ __attribute__((aligned(16))) unsigned char lds[];
    Frame F;
    F.lds = (LAS unsigned char*)lds; F.MISC = (volatile LAS unsigned*)(F.lds + MISC_OFF);
    F.tid = threadIdx.x; F.lane = F.tid & 63; F.wave = __builtin_amdgcn_readfirstlane(F.tid >> 6);
    F.G = gridDim.x; { const int bx = blockIdx.x; F.vcu = (F.G % 8 == 0) ? (bx % 8) * (F.G / 8) + bx / 8 : bx; }
    unsigned char* ws = args.ws;
    F.ctl = (gu32*)(ws + WS_CTL);
    for (int u = F.tid; u < (LDS_BYTES - LDSCTL_OFF) / 4; u += NWAVES * 64) ((LAS unsigned*)(F.lds + LDSCTL_OFF))[u] = 0u;
    __syncthreads();
    const int lo = args.ph_lo, hi = args.ph_hi;
    const bool use_bar = (hi - lo) > 1;
    XcdBarrier bar; bar.bar = (unsigned*)(F.ctl + CW_BAR); bar.x = 0; bar.st = nullptr;
    if (use_bar) bar = xcd_barrier_post((unsigned*)(F.ctl + CW_BAR), F.MISC + 8);
    if (use_bar && F.tid == 0) __hip_atomic_store((unsigned*)(F.ctl + CW_XTAB) + blockIdx.x, 1u + xb_xcc_id(), __ATOMIC_RELAXED, __HIP_MEMORY_SCOPE_AGENT);
    bool xl_ok = false;
#define PH_IN(id) (lo <= (id) && (id) < hi)
#define PH_END(id) do { if ((id) + 1 < hi) xcd_barrier(bar, F.wave == 0); } while (0)
#define PH_END_LOCAL(id) do { if ((id) + 1 < hi) { if (xl_ok) xcc_local_barrier((unsigned*)(F.ctl + CW_XL) + 64 * (blockIdx.x & 7), F.MISC + 11, (unsigned)(F.G >> 3), F.wave == 0); else xcd_barrier(bar, F.wave == 0); } } while (0)

    const float* x = (const float*)args.in[I_X]; const int* pos = (const int*)args.in[I_POS];
    float* h = args.out;
    bf16* hb = (bf16*)(ws + WS_HB); bf16* qb = (bf16*)(ws + WS_Q); bf16* kb = (bf16*)(ws + WS_K); bf16* vb = (bf16*)(ws + WS_V);
    bf16* zb = (bf16*)(ws + WS_Z); bf16* gb = (bf16*)(ws + WS_G); bf16* yb = (bf16*)(ws + WS_Y); bf16* mgb = (bf16*)(ws + WS_MG);
    bf16* actb = (bf16*)(ws + WS_ACT); float* tb = (float*)(ws + WS_T);
    float* cs = (float*)(ws + WS_CS); unsigned long long* ssq = (unsigned long long*)(ws + WS_SSQ); unsigned long long* zst = (unsigned long long*)(ws + WS_ZST);
    const int gw = F.vcu * NWAVES + F.wave, NGW = F.G * NWAVES, lane = F.lane;

    if (PH_IN(0)) {
        LAS float* scr = (LAS float*)(F.lds + F.wave * TP_SCR_BYTES);
        const int nwg_in = (M / 256) * (INW / 256), nrounds_in = (nwg_in + F.G - 1) / F.G, n_idle_wg = nrounds_in * F.G - nwg_in, nconv = n_idle_wg > 0 ? (n_idle_wg * NWAVES * CI_IDLE_PER_WAVE < CI_LAYER ? n_idle_wg * NWAVES * CI_IDLE_PER_WAVE : CI_LAYER) : 0;
        const int nrem = CI_LAYER - nconv;
        for (int it = gw; it < DEPTH * nrem; it += NGW) { const int l = DEPTH - 1 - it / nrem, r = nrem - 1 - it % nrem; convert_item(args, ws, l, r, scr, lane); }
        for (int m0 = gw; m0 < M; m0 += 2 * NGW) {
            f32x4 xv[2][8];
#pragma unroll
            for (int r2 = 0; r2 < 2; ++r2) { const int m = (m0 + r2 * NGW < M) ? m0 + r2 * NGW : m0; const GAS f32x4* xr = (const GAS f32x4*)(x + (size_t)m * DM) + lane;
#pragma unroll
                for (int j = 0; j < 8; ++j) xv[r2][j] = __builtin_nontemporal_load(xr + 64 * j); }
#pragma unroll
            for (int r2 = 0; r2 < 2; ++r2) { const int m = m0 + r2 * NGW; if (m < M) {
                GAS v2u* br = (GAS v2u*)(hb + ((size_t)(m >> 7) * (DM / 64) + (lane >> 4)) * 8192 + (pg8::lds_byte(m & 127, 4 * (lane & 15)) >> 1));
                float sq = 0.f;
#pragma unroll
                for (int j = 0; j < 8; ++j) { const f32x4 v = xv[r2][j]; br[(size_t)j * 4 * 8192 / 4] = (v2u){pk2(v.x, v.y), pk2(v.z, v.w)}; sq += (v.x * v.x + v.y * v.y) + (v.z * v.z + v.w * v.w); }
                sq = wave_sum(sq); if (lane == 0) ssq[m] = fx_enc(sq, FX_SSQ); } }
        }
        for (int i = (blockIdx.x * NWAVES * 64 + F.tid); i < DEPTH * SGUG * CHUNK * CHUNK; i += F.G * NWAVES * 64) {
            const int sx = i & 127, t = (i >> 7) & 127; ((bf16*)(ws + WS_SGUWM))[i] = (sx <= t) ? (bf16)f2bf(((const float*)args.in[I_SGUW])[i]) : (bf16)0; }
        for (int i = (blockIdx.x * NWAVES * 64 + F.tid); i < M * 8; i += F.G * NWAVES * 64) {
            const int m = i >> 3, f = i & 7;
            const float invf[8] = {1.0f, 0.1939227432012558f, 0.03760603070259094f, 0.007292664609849453f, 0.0014142135623842478f, 0.00027424818836152554f, 5.318296098266728e-05f, 1.0313386155758053e-05f};
            float fr = invf[0];
#pragma unroll
            for (int q = 1; q < 8; ++q) fr = (f == q) ? invf[q] : fr;
            const float ang = (float)pos[m] * fr; float c, s; sincos_red(ang, c, s);
            cs[m * 16 + f] = c; cs[m * 16 + 8 + f] = s;
        }
        PH_END(0);
        if (use_bar && lo == 0 && hi == N_PHASES && F.G == 256) {
            int bad = 0;
            for (int j = F.tid; j < F.G; j += NWAVES * 64) { const unsigned v = __hip_atomic_load((unsigned*)(F.ctl + CW_XTAB) + j, __ATOMIC_RELAXED, __HIP_MEMORY_SCOPE_AGENT), r = __hip_atomic_load((unsigned*)(F.ctl + CW_XTAB) + (j & 7), __ATOMIC_RELAXED, __HIP_MEMORY_SCOPE_AGENT); bad |= (v == 0u || v != r) ? 1 : 0; }
            xl_ok = !__syncthreads_or(bad);
        }
    }

    for (int l = 0; l < DEPTH; ++l) {
        const int pb = 1 + l * NPL;
        int tid_l = lane_here() + 64 * F.wave; asm volatile("" : "+v"(tid_l));
        const int lane = tid_l & 63, tidl = tid_l;
        unsigned char* wl = ws + WS_W + (size_t)l * W_LAYER;
        if (PH_IN(pb + 0)) {
            pg8::Gemm g{hb, (const bf16*)(wl + WL_IN), M, INW, DM}; pg8::StaticOrder S; S.init(M, INW, F.G, (int)blockIdx.x, 4);
            pg8::EpiInProj E{ssq + (size_t)(2 * l) * M, (const float*)args.in[I_BIN] + l * INW, cs, zst + (size_t)l * M * 2, qb, kb, vb, zb, gb};
            pg8::gemm_phase<pg8::EpiInProj, pg8::StaticOrder, true, true>(F.lds, g, S, E, F.wave);
            {
                const int nwg_in = (M / 256) * (INW / 256), nrounds_in = (nwg_in + F.G - 1) / F.G, n_idle_wg = nrounds_in * F.G - nwg_in, rank = (nrounds_in - 1) * F.G + (int)blockIdx.x - nwg_in;
                if (n_idle_wg > 0 && rank >= 0 && rank < n_idle_wg) {
                    LAS float* scr = (LAS float*)(F.lds + F.wave * TP_SCR_BYTES);
                    const int nconv = n_idle_wg * NWAVES * CI_IDLE_PER_WAVE < CI_LAYER ? n_idle_wg * NWAVES * CI_IDLE_PER_WAVE : CI_LAYER;
                    for (int k = 0; k < CI_IDLE_PER_WAVE; ++k) { const int r = CI_LAYER - nconv + (rank * NWAVES + F.wave) + k * n_idle_wg * NWAVES; if (r < CI_LAYER) convert_item(args, ws, l, r, scr, lane); } } }
            PH_END(pb + 0);
        }
        if (PH_IN(pb + 1)) {
            typedef short s16x8 __attribute__((ext_vector_type(8)));
            typedef float f32x16 __attribute__((ext_vector_type(16)));
            const int q_ = lane & 31, hh = lane >> 5, wave = F.wave;
            const float* sinks = (const float*)args.in[I_SINKS] + l * NQH;
            for (int ua = F.vcu; ua < (M / 128) * NKVH; ua += F.G) {
                const int hk = ua & 3, blk = ua >> 2, nb = blk & 63, b = blk >> 6;
                const size_t row0 = (size_t)b * SEQ + (size_t)nb * 128;
                s16x8 qfa[2][4];
#pragma unroll
                for (int gi = 0; gi < 2; ++gi)
#pragma unroll
                    for (int ks = 0; ks < 4; ++ks) qfa[gi][ks] = *(const GAS s16x8*)(qb + (row0 + 32 * ((wave & 1) * 2 + gi) + q_) * AW + (hk * 4 + (wave >> 1)) * HD + 16 * ks + 8 * hh);
                LDS_WAIT(); __builtin_amdgcn_s_barrier(); asm volatile("" ::: "memory");
#pragma unroll
                for (int p = 0; p < 4; ++p) { const int chunk = p * 512 + tidl, kx = chunk >> 3, dc = chunk & 7; const bool ok = (nb > 0) || (kx >= 128);
                    v4u kv = (v4u){0u, 0u, 0u, 0u}; if (ok) kv = *(const GAS v4u*)(kb + (row0 + kx - 128) * KVW + hk * HD + dc * 8);
                    *(LAS v4u*)(F.lds + P2_K + kx * P2_KROW + dc * 16) = kv; }
#pragma unroll
                for (int p = 0; p < 4; ++p) { const int chunk = p * 512 + tidl, dc = chunk >> 8, kx = chunk & 255; const bool ok = (nb > 0) || (kx >= 128);
                    v4u vv = (v4u){0u, 0u, 0u, 0u}; if (ok) vv = *(const GAS v4u*)(vb + (row0 + kx - 128) * KVW + hk * HD + dc * 8);
                    const int pos = (kx & ~15) + 8 * ((kx >> 2) & 1) + 4 * ((kx >> 3) & 1) + (kx & 3);
                    LAS unsigned short* vp = (LAS unsigned short*)(F.lds + P2_V + (dc * 8) * P2_VROW + pos * 2);
                    vp[0 * (P2_VROW / 2)] = (unsigned short)(vv.x & 0xffffu); vp[1 * (P2_VROW / 2)] = (unsigned short)(vv.x >> 16);
                    vp[2 * (P2_VROW / 2)] = (unsigned short)(vv.y & 0xffffu); vp[3 * (P2_VROW / 2)] = (unsigned short)(vv.y >> 16);
                    vp[4 * (P2_VROW / 2)] = (unsigned short)(vv.z & 0xffffu); vp[5 * (P2_VROW / 2)] = (unsigned short)(vv.z >> 16);
                    vp[6 * (P2_VROW / 2)] = (unsigned short)(vv.w & 0xffffu); vp[7 * (P2_VROW / 2)] = (unsigned short)(vv.w >> 16); }
                LDS_WAIT(); __builtin_amdgcn_s_barrier(); asm volatile("" ::: "memory");
                const int hq = hk * 4 + (wave >> 1);
                const float sink2 = sinks[hq] * 1.4426950408889634f;
#pragma unroll
                for (int gi = 0; gi < 2; ++gi) {
                    const int tg = (wave & 1) * 2 + gi; const size_t trow = row0 + 32 * tg + q_;
                    s16x8 qf[4];
#pragma unroll
                    for (int ks = 0; ks < 4; ++ks) qf[ks] = qfa[gi][ks];
                    f32x16 st[5];
#pragma unroll
                    for (int jt = 0; jt < 5; ++jt) { const int kt = tg + jt; f32x16 a = {};
#pragma unroll
                        for (int ks = 0; ks < 4; ++ks) { const s16x8 kf = *(const LAS s16x8*)(F.lds + P2_K + (32 * kt + q_) * P2_KROW + (16 * ks + 8 * hh) * 2);
                            a = __builtin_amdgcn_mfma_f32_32x32x16_bf16(kf, qf[ks], a, 0, 0, 0); }
                        st[jt] = a; }
                    const float c2 = 0.125f * 1.4426950408889634f; const float NEGINF = -__builtin_inff();
                    float mx = sink2;
#pragma unroll
                    for (int jt = 0; jt < 5; ++jt) { const bool dead = (nb == 0) && (tg + jt < 4);
#pragma unroll
                        for (int r = 0; r < 16; ++r) { const int i = (r & 3) + 8 * (r >> 2) + 4 * hh; bool ok = !dead; if (jt == 0) ok = ok && (i > q_); if (jt == 4) ok = ok && (i <= q_);
                            const float v = ok ? st[jt][r] * c2 : NEGINF; st[jt][r] = v; mx = fmaxf(mx, v); } }
                    mx = fmaxf(mx, __shfl_xor(mx, 32));
                    float lsum = 0.f;
#pragma unroll
                    for (int jt = 0; jt < 5; ++jt)
#pragma unroll
                        for (int r = 0; r < 16; ++r) { const float pe = __builtin_amdgcn_exp2f(st[jt][r] - mx); st[jt][r] = pe; lsum += pe; }
                    lsum += __shfl_xor(lsum, 32); lsum += __builtin_amdgcn_exp2f(sink2 - mx);
                    f32x16 o0 = {}, o1 = {};
#pragma unroll
                    for (int jt = 0; jt < 5; ++jt) { const int kt = tg + jt;
#pragma unroll
                        for (int sp = 0; sp < 2; ++sp) {
                            v4u pw; pw.x = pg8::cvt_pk_bf16(st[jt][8 * sp + 0], st[jt][8 * sp + 1]); pw.y = pg8::cvt_pk_bf16(st[jt][8 * sp + 2], st[jt][8 * sp + 3]);
                            pw.z = pg8::cvt_pk_bf16(st[jt][8 * sp + 4], st[jt][8 * sp + 5]); pw.w = pg8::cvt_pk_bf16(st[jt][8 * sp + 6], st[jt][8 * sp + 7]);
                            const s16x8 pf = __builtin_bit_cast(s16x8, pw);
                            const s16x8 v0 = *(const LAS s16x8*)(F.lds + P2_V + (q_) * P2_VROW + (32 * kt + 16 * sp + 8 * hh) * 2);
                            const s16x8 v1 = *(const LAS s16x8*)(F.lds + P2_V + (32 + q_) * P2_VROW + (32 * kt + 16 * sp + 8 * hh) * 2);
                            o0 = __builtin_amdgcn_mfma_f32_32x32x16_bf16(v0, pf, o0, 0, 0, 0);
                            o1 = __builtin_amdgcn_mfma_f32_32x32x16_bf16(v1, pf, o1, 0, 0, 0); } }
                    const float inv = 1.0f / lsum;
#pragma unroll
                    for (int rq = 0; rq < 4; ++rq) {
                        *(GAS v2u*)(yb + blk_idx(trow, hq * HD + 4 * hh + 8 * rq, DM)) = (v2u){pg8::cvt_pk_bf16(o0[4 * rq + 0] * inv, o0[4 * rq + 1] * inv), pg8::cvt_pk_bf16(o0[4 * rq + 2] * inv, o0[4 * rq + 3] * inv)};
                        *(GAS v2u*)(yb + blk_idx(trow, hq * HD + 32 + 4 * hh + 8 * rq, DM)) = (v2u){pg8::cvt_pk_bf16(o1[4 * rq + 0] * inv, o1[4 * rq + 1] * inv), pg8::cvt_pk_bf16(o1[4 * rq + 2] * inv, o1[4 * rq + 3] * inv)}; }
                }
            }
            const float* lng = (const float*)args.in[I_LNG] + l * SGUW; const float* lnb = (const float*)args.in[I_LNB] + l * SGUW;
            const float* sbias = (const float*)args.in[I_SGUB] + l * SGUG * CHUNK;
            const bf16* wm_l = (const bf16*)(ws + WS_SGUWM) + (size_t)l * SGUG * CHUNK * CHUNK;
            bf16* ys = yb + AW;
            {
                constexpr int NU = (M / CHUNK) * SGUG;
                const int ct = wave & 3, tt0 = wave >> 2, tt1 = 3 - tt0;
                LAS float* lnp = (LAS float*)(F.lds + P2_LN);
                v4u zv[4], zs[4]; int gcur = -1;
                int us = F.vcu;
#define SGU_ISSUE(us_) do { const int g_ = (us_) & 7; const size_t base_ = (size_t)((us_) >> 3) * CHUNK; \
                    _Pragma("unroll") for (int p = 0; p < 4; ++p) { const int c = p * 512 + tidl, cc = c >> 7, sx = c & 127; \
                        zv[p] = *(const GAS v4u*)(zb + (base_ + sx) * (2 * SGUW) + SGUW + 128 * g_ + cc * 8); zs[p] = *(const GAS v4u*)(zst + ((size_t)l * M + base_ + sx) * 2); } } while (0)
                if (us < NU) SGU_ISSUE(us);
                for (; us < NU; us += F.G) {
                    const int g = us & 7, chunk = us >> 3; const size_t base = (size_t)chunk * CHUNK;
                    v2u uw[2][4];
#pragma unroll
                    for (int ti = 0; ti < 2; ++ti)
#pragma unroll
                        for (int rq = 0; rq < 4; ++rq) uw[ti][rq] = *(const GAS v2u*)(zb + (base + 32 * (ti == 0 ? tt0 : tt1) + q_) * (2 * SGUW) + 128 * g + 32 * ct + 4 * hh + 8 * rq);
                    LDS_WAIT(); __builtin_amdgcn_s_barrier(); asm volatile("" ::: "memory");
                    if (g != gcur) {
                        gcur = g; const bf16* wm = wm_l + (size_t)g * CHUNK * CHUNK;
                        if (tidl < 256) lnp[tidl] = (tidl < 128) ? lng[128 * g + tidl] : lnb[128 * g + tidl - 128];
#pragma unroll
                        for (int p = 0; p < 4; ++p) { const int c = p * 512 + tidl, t = c >> 4, sc = c & 15;
                            *(LAS v4u*)(F.lds + P2_WM + t * P2_SROW + sc * 16) = *(const GAS v4u*)(wm + (size_t)t * CHUNK + sc * 8); }
                        LDS_WAIT(); __builtin_amdgcn_s_barrier(); asm volatile("" ::: "memory"); }
#pragma unroll
                    for (int p = 0; p < 4; ++p) { const int c = p * 512 + tidl, cc = c >> 7, sx = c & 127;
                        const unsigned long long z0 = (unsigned long long)zs[p].x | ((unsigned long long)zs[p].y << 32), z1 = (unsigned long long)zs[p].z | ((unsigned long long)zs[p].w << 32);
                        const double zm = (double)(long long)z0 * (1.0 / (FX_ZST * SGUW)); const double zvar = (double)(long long)z1 * (1.0 / (FX_ZST * SGUW)) - zm * zm; const float mm = (float)zm, rs = 1.0f / sqrtf((float)zvar + EPS);
                        const f32x4 g0 = *(const LAS f32x4*)(lnp + cc * 8), g1 = *(const LAS f32x4*)(lnp + cc * 8 + 4), b0 = *(const LAS f32x4*)(lnp + 128 + cc * 8), b1 = *(const LAS f32x4*)(lnp + 128 + cc * 8 + 4);
                        const v4u zw = zv[p];
                        LAS unsigned short* vp = (LAS unsigned short*)(F.lds + (cc * 8) * P2_SROW + sx * 2);
                        vp[0 * (P2_SROW / 2)] = (unsigned short)f2bf((bflo(zw.x) - mm) * rs * g0[0] + b0[0]); vp[1 * (P2_SROW / 2)] = (unsigned short)f2bf((bfhi(zw.x) - mm) * rs * g0[1] + b0[1]);
                        vp[2 * (P2_SROW / 2)] = (unsigned short)f2bf((bflo(zw.y) - mm) * rs * g0[2] + b0[2]); vp[3 * (P2_SROW / 2)] = (unsigned short)f2bf((bfhi(zw.y) - mm) * rs * g0[3] + b0[3]);
                        vp[4 * (P2_SROW / 2)] = (unsigned short)f2bf((bflo(zw.z) - mm) * rs * g1[0] + b1[0]); vp[5 * (P2_SROW / 2)] = (unsigned short)f2bf((bfhi(zw.z) - mm) * rs * g1[1] + b1[1]);
                        vp[6 * (P2_SROW / 2)] = (unsigned short)f2bf((bflo(zw.w) - mm) * rs * g1[2] + b1[2]); vp[7 * (P2_SROW / 2)] = (unsigned short)f2bf((bfhi(zw.w) - mm) * rs * g1[3] + b1[3]); }
                    if (us + F.G < NU) SGU_ISSUE(us + F.G);
                    LDS_WAIT(); __builtin_amdgcn_s_barrier(); asm volatile("" ::: "memory");
                    f32x16 a0 = {}, a1 = {};
#pragma unroll
                    for (int sk = 0; sk < 8; ++sk) { const s16x8 af = *(const LAS s16x8*)(F.lds + (32 * ct + q_) * P2_SROW + (16 * sk + 8 * hh) * 2);
                        if (sk < 4) a0 = __builtin_amdgcn_mfma_f32_32x32x16_bf16(af, *(const LAS s16x8*)(F.lds + P2_WM + (32 * tt0 + q_) * P2_SROW + (16 * sk + 8 * hh) * 2), a0, 0, 0, 0);
                        a1 = __builtin_amdgcn_mfma_f32_32x32x16_bf16(af, *(const LAS s16x8*)(F.lds + P2_WM + (32 * tt1 + q_) * P2_SROW + (16 * sk + 8 * hh) * 2), a1, 0, 0, 0); }
#pragma unroll
                    for (int ti = 0; ti < 2; ++ti) { const int tt = ti == 0 ? tt0 : tt1; const f32x16 a = ti == 0 ? a0 : a1;
                        const int t = 32 * tt + q_; const size_t row = base + t; const float bs = sbias[g * CHUNK + t];
                        const int ch0 = 128 * g + 32 * ct + 4 * hh;
#pragma unroll
                        for (int rq = 0; rq < 4; ++rq) { const v2u u2 = uw[ti][rq];
                            *(GAS v2u*)(yb + blk_idx(row, AW + ch0 + 8 * rq, DM)) = (v2u){pg8::cvt_pk_bf16(bflo(u2.x) * (a[4 * rq + 0] + bs), bfhi(u2.x) * (a[4 * rq + 1] + bs)), pg8::cvt_pk_bf16(bflo(u2.y) * (a[4 * rq + 2] + bs), bfhi(u2.y) * (a[4 * rq + 3] + bs))}; } }
                }
#undef SGU_ISSUE
            }
            LDS_WAIT(); __builtin_amdgcn_s_barrier(); asm volatile("" ::: "memory");
            PH_END(pb + 1);
        }
        if (PH_IN(pb + 2)) {
            pg8::Gemm g{yb, (const bf16*)(wl + WL_AB), M, DM, DM}; pg8::StaticOrder S; S.init(M, DM, F.G, (int)blockIdx.x, 4);
            pg8::EpiGate E{gb, gb + (size_t)M * DM, mgb};
            pg8::gemm_phase<pg8::EpiGate, pg8::StaticOrder, true, true>(F.lds, g, S, E, F.wave);
            PH_END_LOCAL(pb + 2);
        }
        if (PH_IN(pb + 3)) {
            pg8::Gemm g{mgb, (const bf16*)(wl + WL_OUT), M, DM, DM}; pg8::StaticOrder S; S.init(M, DM, F.G, (int)blockIdx.x, 4);
            pg8::EpiResid E{nullptr, hb, ssq + (size_t)(2 * l + 1) * M};
            pg8::gemm_phase<pg8::EpiResid, pg8::StaticOrder, true, true>(F.lds, g, S, E, F.wave);
            PH_END_LOCAL(pb + 3);
        }
        if (PH_IN(pb + 4)) {
            pg8::Gemm g{hb, (const bf16*)(wl + WL_GU), M, 2 * DFF, DM}; pg8::StaticOrder S; S.init(M, 2 * DFF, F.G, (int)blockIdx.x, 4);
            pg8::EpiSwiglu E{ssq + (size_t)(2 * l + 1) * M, actb};
            pg8::gemm_phase<pg8::EpiSwiglu, pg8::StaticOrder, true, true>(F.lds, g, S, E, F.wave);
            PH_END_LOCAL(pb + 4);
        }
        if (PH_IN(pb + 5)) {
            pg8::Gemm g{actb, (const bf16*)(wl + WL_DN), M, DM, DFF}; pg8::StaticOrder S; S.init(M, DM, F.G, (int)blockIdx.x, 4);
            pg8::EpiResid E{nullptr, hb, ssq + (size_t)(2 * l + 2) * M};
            pg8::gemm_phase<pg8::EpiResid, pg8::StaticOrder, true, true>(F.lds, g, S, E, F.wave);
            if (l + 1 < DEPTH) PH_END_LOCAL(pb + 5); else PH_END(pb + 5);
        }
    }
    if (PH_IN(N_PHASES - 1)) {
        const float* fg = (const float*)args.in[I_FG];
        int lane_f = lane_here(); asm volatile("" : "+v"(lane_f));
        const int lane = lane_f;
        const int NGWF = F.G * NWAVES;
        for (int m0 = F.vcu * NWAVES + F.wave; m0 < M; m0 += 2 * NGWF) {
            v2u hw[2][8]; float rs[2];
#pragma unroll
            for (int r2 = 0; r2 < 2; ++r2) { const int m = (m0 + r2 * NGWF < M) ? m0 + r2 * NGWF : m0;
                const GAS v2u* br = (const GAS v2u*)(hb + ((size_t)(m >> 7) * (DM / 64) + (lane >> 4)) * 8192 + (pg8::lds_byte(m & 127, 4 * (lane & 15)) >> 1));
#pragma unroll
                for (int j = 0; j < 8; ++j) hw[r2][j] = br[(size_t)j * 8192];
                rs[r2] = rstd_from_ssq(ssq + (size_t)(2 * DEPTH) * M + m); }
            const GAS f32x4* gr = (const GAS f32x4*)fg + lane;
#pragma unroll
            for (int r2 = 0; r2 < 2; ++r2) { const int m = m0 + r2 * NGWF; if (m < M) { GAS f32x4* orow = (GAS f32x4*)(h + (size_t)m * DM) + lane;
#pragma unroll
                for (int j = 0; j < 8; ++j) { const v2u w = hw[r2][j]; const f32x4 v = (f32x4){bflo(w.x), bfhi(w.x), bflo(w.y), bfhi(w.y)}; orow[64 * j] = v * rs[r2] * gr[64 * j]; } } } }
    }
#undef PH_IN
#undef PH_END
#undef PH_END_LOCAL
}

extern "C" void kernel_launch(void* const* d_in, const int* in_sizes, int n_in, void* d_out, int out_size, void* d_ws, size_t ws_size, hipStream_t stream) {
    static int grid = 0;
    if (grid == 0) {
        if (n_in != 17 || in_sizes[0] != M * DM || out_size != M * DM || ws_size < WS_END) { fprintf(stderr, "kernel_launch: unexpected shapes (n_in %d, in0 %d, out %d, ws %zu < %zu); nothing launched\n", n_in, n_in > 0 ? in_sizes[0] : -1, out_size, ws_size, (size_t)WS_END); grid = -1; return; }
        int dev = 0, cus = 0, per_cu = 0;
        if (hipGetDevice(&dev) != hipSuccess || hipDeviceGetAttribute(&cus, hipDeviceAttributeMultiprocessorCount, dev) != hipSuccess) { grid = -1; return; }
        if (hipFuncSetAttribute((const void*)fwd, hipFuncAttributeMaxDynamicSharedMemorySize, LDS_BYTES) != hipSuccess) { fprintf(stderr, "kernel_launch: hipFuncSetAttribute failed\n"); grid = -1; return; }
        if (hipOccupancyMaxActiveBlocksPerMultiprocessor(&per_cu, (const void*)fwd, NWAVES * 64, LDS_BYTES) != hipSuccess || per_cu < 1) fprintf(stderr, "kernel_launch: occupancy query reports %d\n", per_cu);
        (void)hipGetLastError();
        grid = cus;
    }
    if (grid < 0) return;
    if (hipMemsetAsync((char*)d_ws + WS_CTL, 0, CTL_ZERO_BYTES, stream) != hipSuccess) return;
    Args a{};
    for (int i = 0; i < 17; ++i) a.in[i] = d_in[i];
    a.out = (float*)d_out; a.ws = (unsigned char*)d_ws; a.li = 0; a.pad = 0;
#if MK_ONE_LAUNCH
    a.ph_lo = 0; a.ph_hi = N_PHASES;
    hipLaunchKernelGGL(fwd, dim3(grid), dim3(NWAVES * 64), LDS_BYTES, stream, a);
#else
    for (int p = 0; p < N_PHASES; ++p) { a.ph_lo = p; a.ph_hi = p + 1; hipLaunchKernelGGL(fwd, dim3(grid), dim3(NWAVES * 64), LDS_BYTES, stream, a); }
#endif
}
```

```cpp
#include <hip/hip_runtime.h>
#include <cstdio>
#include <cstdint>
__device__ __forceinline__ int lane_here() { unsigned z = 0u; asm volatile("" : "+v"(z)); return (int)__builtin_amdgcn_mbcnt_hi(~0u, __builtin_amdgcn_mbcnt_lo(~0u, z)); }
namespace pg8 {
#define PG8_LAS __attribute__((address_space(3)))
typedef unsigned short bf16_t;
typedef short bf16x8 __attribute__((ext_vector_type(8)));
typedef float f32x4 __attribute__((ext_vector_type(4)));
typedef unsigned u32x4 __attribute__((ext_vector_type(4)));
constexpr int BM = 256, BK = 64, HALF = 128, HTB = HALF * BK * 2  , STAGE_BYTES = 8 * HTB, NXCD = 8, WGM = 8;

__host__ __device__ __forceinline__ int lds_byte(int r, int c) { const int st = (r >> 4) * 2 + (c >> 5), rr = r & 15, cc = c & 31, ob = rr * 64 + cc * 2; return st * 1024 + (ob ^ (((ob >> 9) & 1) << 5)); }
__host__ __device__ __forceinline__ void stage_rc(int b, int& R, int& C) { const int st = b / 1024, sb = b % 1024, swz = sb ^ (((sb >> 9) & 1) << 5); R = (st >> 1) * 16 + swz / 64; C = (st & 1) * 32 + (swz % 64) / 2; }
__host__ __device__ __forceinline__ int perm32(int rho) { const int n = rho >> 4, i = rho & 15; return 8 * (i >> 2) + 4 * n + (i & 3); }

struct Unit { int pm, pn; };
struct Gemm { const bf16_t* A; const bf16_t* Bt; int M, N, K; };

struct StaticOrder {
    int nM, nN, nwg, G, c, wgm;
    __host__ __device__ void init(int M, int N, int G_, int c_, int wgm_ = WGM) { nM = M / BM; nN = N / BM; nwg = nM * nN; G = G_; c = c_; wgm = wgm_; }
    __host__ __device__ bool next(int i, Unit& u) const {
        const long L = (long)i * G + c; if (L >= nwg) return false;
        int wgid = (int)L; { const int q = nwg / NXCD, r = nwg % NXCD, xcd = wgid % NXCD, off = wgid / NXCD; wgid = (xcd < r ? xcd * (q + 1) : r * (q + 1) + (xcd - r) * q) + off; }
        const int nig = wgm * nN, gid = wgid / nig, fm = gid * wgm, gsz = (nM - fm) < wgm ? (nM - fm) : wgm;
        u.pm = fm + ((wgid % nig) % gsz); u.pn = (wgid % nig) / gsz; return true;
    }
    __device__ __forceinline__ void a_ready(const Unit&) const {}
    __device__ __forceinline__ void done(const Unit&) const {}
};

__device__ __forceinline__ unsigned cvt_pk_bf16(float lo, float hi) { unsigned r; asm volatile("v_cvt_pk_bf16_f32 %0, %1, %2" : "=v"(r) : "v"(lo), "v"(hi)); return r; }
typedef float f32x2 __attribute__((ext_vector_type(2)));
__device__ __forceinline__ f32x2 gelu_pk(f32x2 v) {
    const f32x2 av = __builtin_elementwise_abs(v), d = av * 0.2316418882f + 1.0f;
    f32x2 t; t.x = __builtin_amdgcn_rcpf(d.x); t.y = __builtin_amdgcn_rcpf(d.y);
    f32x2 q = t * 0.5307027145f + (-0.7265760135f); q = q * t + 0.7107068705f; q = q * t + (-0.142248368f); q = q * t + 0.127414796f; q = q * t;
    const f32x2 s = (v * v) * (-0.72134752044f);
    f32x2 e; e.x = __builtin_amdgcn_exp2f(s.x); e.y = __builtin_amdgcn_exp2f(s.y);
    const f32x2 m = v * (q * e), r = v - m;
    f32x2 o; o.x = v.x < 0.f ? m.x : r.x; o.y = v.y < 0.f ? m.y : r.y; return o;
}

template <int ACT  > struct EpiBf16 {
    static constexpr bool PERM = true, AFTER_DRAIN = false; static constexpr int MID_T = 0; static constexpr bool BLOCKED = false; static_assert(ACT == 0 || ACT == 1, "EpiBf16: ACT is 0 (none) or 1 (gelu_pk)");
    bf16_t* O; int ldc; const float* bias; int split_cols; size_t split_stride; float scale0;
    __device__ __forceinline__ void operator()(const f32x4 (&acc)[2][2][4][2], const Unit& u, int wr, int wc, int fr, int fq) const {
        const int row0 = u.pm * BM + wr * 64 + fr; int colt = u.pn * BM; bf16_t* base = O;
        float sc = 1.f; if (split_cols) { const int t = colt / split_cols; base += (size_t)t * split_stride; colt -= t * split_cols; if (t == 0) sc = scale0; }
        const int col0 = colt + wc * 32 + 8 * fq, bcol0 = u.pn * BM + wc * 32 + 8 * fq;
        f32x4 bv[2][2];
#pragma unroll
        for (int bj = 0; bj < 2; ++bj)
#pragma unroll
            for (int n = 0; n < 2; ++n) bv[bj][n] = bias ? *(const f32x4*)(bias + bcol0 + bj * HALF + 4 * n) : (f32x4){0.f, 0.f, 0.f, 0.f};
#pragma unroll
        for (int ai = 0; ai < 2; ++ai)
#pragma unroll
            for (int m = 0; m < 4; ++m) { bf16_t* rowp = base + (size_t)(row0 + ai * HALF + m * 16) * ldc + col0;
#pragma unroll
                for (int bj = 0; bj < 2; ++bj) { f32x4 v0 = acc[ai][bj][m][0] + bv[bj][0], v1 = acc[ai][bj][m][1] + bv[bj][1];
                    if (ACT == 1) { f32x2 a = gelu_pk((f32x2){v0[0], v0[1]}), b = gelu_pk((f32x2){v0[2], v0[3]}), c = gelu_pk((f32x2){v1[0], v1[1]}), d = gelu_pk((f32x2){v1[2], v1[3]});
                        v0 = (f32x4){a.x, a.y, b.x, b.y}; v1 = (f32x4){c.x, c.y, d.x, d.y}; }
                    v0 = v0 * sc; v1 = v1 * sc; u32x4 w; w.x = cvt_pk_bf16(v0[0], v0[1]); w.y = cvt_pk_bf16(v0[2], v0[3]); w.z = cvt_pk_bf16(v1[0], v1[1]); w.w = cvt_pk_bf16(v1[2], v1[3]);
                    *(u32x4*)(rowp + bj * HALF) = w; } }
    }
};


template <class Epi, class Sched, bool ALIGN_EPI = false, bool SP2 = false>
__device__ __forceinline__ void gemm_phase(PG8_LAS unsigned char* lds, const Gemm g, const Sched& S, const Epi& E, const int wave_id) {
    int tid_ = lane_here() + 64 * wave_id; asm volatile("" : "+v"(tid_));
    const int tid = tid_, wid = __builtin_amdgcn_readfirstlane(tid >> 6), lane = tid & 63, wr = wid >> 2, wc = wid & 3, fr = lane & 15, fq = lane >> 4;
    const int K = g.K, nt = K / BK;
    unsigned voffA[2], voffB[2];
#pragma unroll
    for (int i = 0; i < 2; ++i) { int R, C; stage_rc(tid * 16 + i * 8192, R, C); const int Rb = Epi::PERM ? ((R & ~31) + perm32(R & 31)) : R;
        (void)R; (void)C; (void)Rb; voffA[i] = (unsigned)(tid * 16 + i * 8192); voffB[i] = voffA[i]; }
    const unsigned kstep = (unsigned)(HALF * BK * 2);
    const unsigned hstep = (unsigned)HALF * (unsigned)K * 2u;
    const unsigned tstep = 2u * hstep;
    const unsigned ldsw = (unsigned)wid * 1024u;
    const int aoff = lds_byte(wr * 64 + fr, fq * 8), boff = lds_byte(wc * 32 + fr, fq * 8);
#define PG8_SA(b, h) (((b) * 2 + (h)) * HTB)
#define PG8_SB(b, h) ((4 + (b) * 2 + (h)) * HTB)
    const __amdgpu_buffer_rsrc_t srdA = __builtin_amdgcn_make_buffer_rsrc((void*)g.A, (short)0, (int)((size_t)g.M * (size_t)K * 2), 0x00020000);
    const __amdgpu_buffer_rsrc_t srdB = __builtin_amdgcn_make_buffer_rsrc((void*)g.Bt, (short)0, (int)((size_t)g.N * (size_t)K * 2), 0x00020000);
    const unsigned ldsb = __builtin_amdgcn_readfirstlane((unsigned)(__UINTPTR_TYPE__)lds);
#define PG8_STAGEX(srd, bufoff, off32, voff) do { _Pragma("unroll") for (int _i = 0; _i < 2; ++_i) { const unsigned m0_ = ldsb + (unsigned)(bufoff) + ldsw + (unsigned)(_i * 8192); const unsigned so_ = (unsigned)(off32); \
        asm volatile("s_mov_b32 m0, %0\n\ts_nop 0\n\tbuffer_load_dwordx4 %1, %2, %3 offen lds" :: "s"(m0_), "v"((voff)[_i]), "s"(srd), "s"(so_) : "m0", "memory"); } } while (0)
#define PG8_STAGEA(bufoff, off32, voff) PG8_STAGEX(srdA, bufoff, off32, voff)
#define PG8_STAGEB(bufoff, off32, voff) PG8_STAGEX(srdB, bufoff, off32, voff)
#define PG8_LDA(dst, b, h) do { _Pragma("unroll") for (int m = 0; m < 4; ++m) _Pragma("unroll") for (int k = 0; k < 2; ++k) dst[m][k] = *(const PG8_LAS bf16x8*)(lds + PG8_SA(b, h) + aoff + m * 2048 + k * 1024); } while (0)
#define PG8_LDB(dst, b, h) do { _Pragma("unroll") for (int n = 0; n < 2; ++n) _Pragma("unroll") for (int k = 0; k < 2; ++k) dst[n][k] = *(const PG8_LAS bf16x8*)(lds + PG8_SB(b, h) + boff + n * 2048 + k * 1024); } while (0)
#define PG8_MMA(ai, bj, At, Bt) do { __builtin_amdgcn_s_setprio(1); _Pragma("unroll") for (int m = 0; m < 4; ++m) _Pragma("unroll") for (int n = 0; n < 2; ++n) _Pragma("unroll") for (int k = 0; k < 2; ++k) \
        acc[ai][bj][m][n] = __builtin_amdgcn_mfma_f32_16x16x32_bf16(Bt[n][k], At[m][k], acc[ai][bj][m][n], 0, 0, 0); __builtin_amdgcn_s_setprio(0); } while (0)
#define PG8_WAIT_V(n) asm volatile("s_waitcnt vmcnt(" #n ")" ::: "memory")
#define PG8_WAIT_L(n) asm volatile("s_waitcnt lgkmcnt(" #n ")" ::: "memory")
#define PG8_BAR __builtin_amdgcn_s_barrier()
#define PG8_SCHED __builtin_amdgcn_sched_barrier(0)
    Unit cur, nxt; int ui = 0;
    if (!S.next(0, cur)) return;
    f32x4 acc[2][2][4][2];
#pragma unroll
    for (int a = 0; a < 2; ++a)
#pragma unroll
        for (int b = 0; b < 2; ++b)
#pragma unroll
            for (int m = 0; m < 4; ++m)
#pragma unroll
                for (int n = 0; n < 2; ++n) acc[a][b][m][n] = (f32x4){0.f, 0.f, 0.f, 0.f};
    bf16x8 At[4][2], B0[2][2], B1[2][2];
    unsigned cA = (unsigned)cur.pm * tstep, cB = (unsigned)cur.pn * tstep;
    S.a_ready(cur);
    if constexpr (SP2) {
        PG8_STAGEB(PG8_SB(0, 0), cB, voffB); PG8_STAGEB(PG8_SB(0, 1), cB + hstep, voffB); PG8_STAGEA(PG8_SA(0, 0), cA, voffA); PG8_STAGEA(PG8_SA(0, 1), cA + hstep, voffA);
        if (wr == 1) PG8_BAR;
        PG8_WAIT_V(2); PG8_BAR;
        PG8_STAGEB(PG8_SB(1, 0), cB + kstep, voffB); PG8_STAGEA(PG8_SA(1, 0), cA + kstep, voffA); PG8_STAGEB(PG8_SB(1, 1), cB + hstep + kstep, voffB);
        PG8_WAIT_V(6); PG8_BAR;
    } else {
        PG8_STAGEB(PG8_SB(0, 0), cB, voffB); PG8_STAGEA(PG8_SA(0, 0), cA, voffA); PG8_STAGEB(PG8_SB(0, 1), cB + hstep, voffB); PG8_STAGEA(PG8_SA(0, 1), cA + hstep, voffA);
        if (wr == 1) PG8_BAR;
        PG8_WAIT_V(4); PG8_BAR;
        PG8_STAGEB(PG8_SB(1, 0), cB + kstep, voffB); PG8_STAGEA(PG8_SA(1, 0), cA + kstep, voffA); PG8_STAGEB(PG8_SB(1, 1), cB + hstep + kstep, voffB);
        PG8_WAIT_V(6); PG8_BAR;
    }
    for (;;) {
        const bool has_next = S.next(ui + 1, nxt);
        const unsigned nA = has_next ? (unsigned)nxt.pm * tstep : cA, nB = has_next ? (unsigned)nxt.pn * tstep : cB;
        for (int t = 0; t < nt; t += 2) {
            if constexpr (Epi::MID_T > 0) { if (t == Epi::MID_T) E.mid(acc, cur, wr, wc, fr, fq); }
            const bool last = (t == nt - 2);
            const unsigned a1 = cA + (unsigned)(t + 1) * kstep;
            const unsigned a2 = last ? nA : cA + (unsigned)(t + 2) * kstep, b2 = last ? nB : cB + (unsigned)(t + 2) * kstep;
            const unsigned a3 = a2 + kstep, b3 = b2 + kstep;
            if (last && has_next) S.a_ready(nxt);
            if constexpr (SP2) {
            PG8_LDB(B0, 0, 0); PG8_LDB(B1, 0, 1); PG8_SCHED; PG8_LDA(At, 0, 0); PG8_STAGEA(PG8_SA(1, 1), a1 + hstep, voffA);
            PG8_WAIT_V(8); PG8_WAIT_L(0); PG8_BAR; PG8_MMA(0, 0, At, B0); PG8_MMA(0, 1, At, B1); PG8_BAR; PG8_SCHED;
            PG8_LDA(At, 0, 1); PG8_STAGEB(PG8_SB(0, 0), b2, voffB); PG8_STAGEB(PG8_SB(0, 1), b2 + hstep, voffB); PG8_STAGEA(PG8_SA(0, 0), a2, voffA);
            PG8_WAIT_V(8); PG8_WAIT_L(0); PG8_BAR; PG8_MMA(1, 0, At, B0); PG8_MMA(1, 1, At, B1); PG8_BAR; PG8_SCHED;
            PG8_LDB(B0, 1, 0); PG8_LDB(B1, 1, 1); PG8_SCHED; PG8_LDA(At, 1, 0); PG8_STAGEA(PG8_SA(0, 1), a2 + hstep, voffA);
            PG8_WAIT_V(8); PG8_WAIT_L(0); PG8_BAR; PG8_MMA(0, 0, At, B0); PG8_MMA(0, 1, At, B1); PG8_BAR; PG8_SCHED;
            PG8_LDA(At, 1, 1); PG8_STAGEB(PG8_SB(1, 0), b3, voffB); PG8_STAGEB(PG8_SB(1, 1), b3 + hstep, voffB); PG8_STAGEA(PG8_SA(1, 0), a3, voffA);
            PG8_WAIT_V(8); PG8_WAIT_L(0); PG8_BAR; PG8_MMA(1, 0, At, B0); PG8_MMA(1, 1, At, B1); PG8_BAR; PG8_SCHED;
            } else {
            PG8_LDB(B0, 0, 0); PG8_SCHED; PG8_LDA(At, 0, 0); PG8_STAGEA(PG8_SA(1, 1), a1 + hstep, voffA);
            PG8_WAIT_L(8); PG8_BAR; PG8_WAIT_L(0); PG8_MMA(0, 0, At, B0); PG8_BAR; PG8_SCHED;
            PG8_LDB(B1, 0, 1); PG8_STAGEB(PG8_SB(0, 0), b2, voffB);
            PG8_BAR; PG8_WAIT_L(0); PG8_MMA(0, 1, At, B1); PG8_BAR;
            PG8_LDA(At, 0, 1); PG8_STAGEA(PG8_SA(0, 0), a2, voffA);
            PG8_BAR; PG8_WAIT_L(0); PG8_MMA(1, 0, At, B0); PG8_BAR; PG8_SCHED;
            PG8_STAGEB(PG8_SB(0, 1), b2 + hstep, voffB);
            PG8_WAIT_V(6); PG8_BAR; PG8_MMA(1, 1, At, B1); PG8_BAR;
            PG8_LDB(B0, 1, 0); PG8_SCHED; PG8_LDA(At, 1, 0); PG8_STAGEA(PG8_SA(0, 1), a2 + hstep, voffA);
            PG8_WAIT_L(8); PG8_BAR; PG8_WAIT_L(0); PG8_MMA(0, 0, At, B0); PG8_BAR; PG8_SCHED;
            PG8_LDB(B1, 1, 1); PG8_STAGEB(PG8_SB(1, 0), b3, voffB);
            PG8_BAR; PG8_WAIT_L(0); PG8_MMA(0, 1, At, B1); PG8_BAR;
            PG8_LDA(At, 1, 1); PG8_STAGEA(PG8_SA(1, 0), a3, voffA);
            PG8_BAR; PG8_WAIT_L(0); PG8_MMA(1, 0, At, B0); PG8_BAR; PG8_SCHED;
            PG8_STAGEB(PG8_SB(1, 1), b3 + hstep, voffB);
            PG8_WAIT_V(6); PG8_BAR; PG8_MMA(1, 1, At, B1); PG8_BAR;
            }
        }
        if constexpr (ALIGN_EPI) { if (wr == 0) PG8_BAR; }
        if constexpr (!Epi::AFTER_DRAIN) { E(acc, cur, wr, wc, fr, fq); S.done(cur); }
        if (!has_next) break;
#pragma unroll
        for (int a = 0; a < 2; ++a)
#pragma unroll
            for (int b = 0; b < 2; ++b)
#pragma unroll
                for (int m = 0; m < 4; ++m)
#pragma unroll
                    for (int n = 0; n < 2; ++n) acc[a][b][m][n] = (f32x4){0.f, 0.f, 0.f, 0.f};
        cur = nxt; cA = nA; cB = nB; ++ui;
        if constexpr (ALIGN_EPI) { if (wr == 1) PG8_BAR; }
    }
    PG8_WAIT_V(0);
    if constexpr (!ALIGN_EPI) { if (wr == 0) PG8_BAR; }
    PG8_BAR;
    if constexpr (Epi::AFTER_DRAIN) { E.fused(acc, cur, wr, wc, fr, fq, lds, wid, lane); S.done(cur); }
#undef PG8_SA
#undef PG8_SB
#undef PG8_STAGEX
#undef PG8_STAGEA
#undef PG8_STAGEB
#undef PG8_LDA
#undef PG8_LDB
#undef PG8_MMA
#undef PG8_WAIT_V
#undef PG8_WAIT_L
#undef PG8_BAR
#undef PG8_SCHED
}
}

#define GAS __attribute__((address_space(1)))
#define LAS __attribute__((address_space(3)))
typedef unsigned short bf16;
typedef unsigned v4u __attribute__((ext_vector_type(4)));
typedef float f32x4 __attribute__((ext_vector_type(4)));
typedef short bf16x8 __attribute__((ext_vector_type(8)));
typedef GAS unsigned gu32;
typedef GAS unsigned long long gu64;
#define RLX_AGENT __ATOMIC_RELAXED, __HIP_MEMORY_SCOPE_AGENT
#define LDS_WAIT() asm volatile("s_waitcnt lgkmcnt(0)" ::: "memory")
#define VM_WAIT() asm volatile("s_waitcnt vmcnt(0)" ::: "memory")
__device__ __forceinline__ unsigned long long rt() { return __builtin_amdgcn_s_memrealtime(); }
__device__ __forceinline__ unsigned f2bf(float f) { unsigned u = __builtin_bit_cast(unsigned, f); return (u + 0x7fffu + ((u >> 16) & 1u)) >> 16; }
__device__ __forceinline__ unsigned pk2(float lo, float hi) { return f2bf(lo) | (f2bf(hi) << 16); }

#define XB_TMO      128
#define XB_XCNT(j)  (256  + 64 * (j))
#define XB_XSUB(j)  (1280 + 64 * (j))
#define XB_XGEN(j)  (2304 + 64 * (j))
#define XB_TOP      3328
#define XB_TOPGEN   3392
#define XCD_BAR_WORDS 3456
#define XB_SPIN_CAP (1u << 18)

__device__ __forceinline__ unsigned xb_ld(unsigned* p)              { return __hip_atomic_load(p, __ATOMIC_RELAXED, __HIP_MEMORY_SCOPE_AGENT); }
__device__ __forceinline__ unsigned xb_add(unsigned* p, unsigned v) { return __hip_atomic_fetch_add(p, v, __ATOMIC_RELAXED, __HIP_MEMORY_SCOPE_AGENT); }
__device__ __forceinline__ unsigned xb_xcc_id() { return (unsigned)__builtin_amdgcn_s_getreg((3 << 11) | 20) & 0xFu; }
#define XB_SPIN(cond, bar) do { unsigned _sp = 0; while (cond) { __builtin_amdgcn_s_sleep(1); \
    if ((++_sp & 255u) == 0u) { if (xb_ld(&(bar)[XB_TMO])) break; if (_sp > XB_SPIN_CAP) { atomicAdd(&(bar)[XB_TMO], 1u); break; } } } } while (0)

struct XcdBarrier {
    unsigned* bar; unsigned x;
    volatile LAS unsigned* st;
};

__device__ __forceinline__ XcdBarrier xcd_barrier_post(unsigned* bar, volatile LAS unsigned* st) {
    XcdBarrier b; b.bar = bar; b.x = xb_xcc_id(); b.st = st;
    if (threadIdx.x == 0) (void)xb_add(&bar[XB_XCNT(b.x)], 1u);
    return b;
}
__device__ __forceinline__ void xcd_barrier_complete(unsigned* bar, unsigned x, unsigned& nloc, unsigned& nx) {
    const unsigned G = gridDim.x * gridDim.y * gridDim.z;
    unsigned sum, cnt, mine, sp = 0u;
    for (;;) {
        sum = 0u; cnt = 0u; mine = 0u;
#pragma unroll
        for (unsigned j = 0; j < 16; ++j) { const unsigned c = xb_ld(&bar[XB_XCNT(j)]); sum += c; cnt += (c > 0u) ? 1u : 0u; mine = (j == x) ? c : mine; }
        if (sum == G) break;
        __builtin_amdgcn_s_sleep(1);
        if ((++sp & 255u) == 0u) { if (xb_ld(&bar[XB_TMO])) break; if (sp > XB_SPIN_CAP) { atomicAdd(&bar[XB_TMO], 1u); break; } }
    }
    nloc = mine > 0u ? mine : 1u; nx = cnt > 0u ? cnt : 1u;
}

__device__ __forceinline__ void xcd_barrier(const XcdBarrier& b, const bool xb_wave0, const bool rel = true) {
    asm volatile("s_waitcnt vmcnt(0)" ::: "memory");
    __syncthreads();
    if (xb_wave0 && lane_here() == 0) {
        unsigned* bar = b.bar;
        __builtin_amdgcn_s_waitcnt(0);
        unsigned nloc = b.st[0], nx = b.st[1];
        if (nloc == 0u) { xcd_barrier_complete(bar, b.x, nloc, nx); b.st[0] = nloc; b.st[1] = nx; }
        const unsigned old = xb_add(&bar[XB_XSUB(b.x)], 1u);
        const unsigned gen = old / nloc;
        if (old + 1u == (gen + 1u) * nloc) {
            if (rel) __builtin_amdgcn_fence(__ATOMIC_RELEASE, "agent");
            asm volatile("s_waitcnt vmcnt(0)" ::: "memory");
            const unsigned og = xb_add(&bar[XB_TOP], 1u);
            const unsigned tg = og / nx;
            __builtin_amdgcn_fence(__ATOMIC_ACQUIRE, "agent");
            if (og + 1u == (tg + 1u) * nx) xb_add(&bar[XB_TOPGEN], 1u);
            else XB_SPIN(xb_ld(&bar[XB_TOPGEN]) == tg, bar);
            xb_add(&bar[XB_XGEN(b.x)], 1u);
            asm volatile("s_waitcnt vmcnt(0)" ::: "memory");
        } else {
            __builtin_amdgcn_fence(__ATOMIC_ACQUIRE, "agent");
            XB_SPIN(xb_ld(&bar[XB_XGEN(b.x)]) == gen, bar);
            asm volatile("s_waitcnt vmcnt(0)" ::: "memory");
        }
    }
    __syncthreads();
}


__device__ __forceinline__ void xcc_local_barrier(unsigned* ctr, volatile LAS unsigned* st, const unsigned nwg_cls, const bool xb_wave0) {
    asm volatile("s_waitcnt vmcnt(0)" ::: "memory");
    __syncthreads();
    if (xb_wave0 && lane_here() == 0) {
        const unsigned k = st[0] + 1u;
        (void)xb_add(ctr, 1u);
        __builtin_amdgcn_fence(__ATOMIC_ACQUIRE, "agent");
        { unsigned sp = 0u; while (xb_ld(ctr) < k * nwg_cls) { __builtin_amdgcn_s_sleep(1); if (++sp > (1u << 22)) break; } }
        asm volatile("s_waitcnt vmcnt(0)" ::: "memory");
        st[0] = k;
    }
    __syncthreads();
}

constexpr int NWAVES = 8;
#ifndef MK_ONE_LAUNCH
#define MK_ONE_LAUNCH 1
#endif
constexpr int BATCH = 2, SEQ = 8192, M = BATCH * SEQ, DM = 2048, DEPTH = 4;
constexpr int NQH = 16, NKVH = 4, HD = 64, AW = 1024, KVW = 256, WIN = 128;
constexpr int SGUW = 1024, SGUG = 8, CHUNK = 128, DFF = 5632;
constexpr int OFF_Q = 0, OFF_K = 1024, OFF_V = 1280, OFF_Z = 1536, OFF_G = 3584, INW = 7680;
constexpr float EPS = 1e-5f;

constexpr size_t MiB = 1u << 20;
constexpr size_t WS_CTL = 0, CTL_ZERO_BYTES = 4 * MiB;
constexpr size_t WS_SSQ = 1 * MiB;
constexpr size_t WS_ZST = 2 * MiB + 512 * 1024;
constexpr size_t WS_CS = 4 * MiB;
constexpr size_t WS_W = 8 * MiB, W_LAYER = 112 * MiB;
constexpr size_t WL_IN = 0, WL_AB = 30 * MiB, WL_SB = 34 * MiB, WL_OUT = 38 * MiB, WL_GU = 46 * MiB, WL_DN = 90 * MiB;
constexpr size_t WS_HB = WS_W + DEPTH * W_LAYER;
constexpr size_t WS_Q = WS_HB + 64 * MiB, WS_K = WS_Q + 32 * MiB, WS_V = WS_K + 8 * MiB;
constexpr size_t WS_Z = WS_V + 8 * MiB;
constexpr size_t WS_G = WS_Z + 64 * MiB;
constexpr size_t WS_Y = WS_G + 128 * MiB;
constexpr size_t WS_MG = WS_Y + 64 * MiB;
constexpr size_t WS_ACT = WS_MG + 64 * MiB;
constexpr size_t WS_T = WS_ACT;
constexpr size_t WS_END = WS_ACT + 176 * MiB;
static_assert((size_t)INW * DM * 2 <= 30 * MiB && (size_t)2 * DM * DFF * 2 <= 44 * MiB && (size_t)DM * DFF * 2 <= 22 * MiB, "weight map");
static_assert((size_t)M * DFF * 2 <= 176 * MiB && (size_t)M * DM * 4 <= 176 * MiB, "act map");
constexpr int CW_BAR = 4096, CW_XTAB = 16384, CW_XL = 20480;
constexpr size_t WS_SGUWM = 5 * MiB;
constexpr int P2_KROW = 144, P2_VROW = 528, P2_SROW = 272, P2_K = 0, P2_V = 256 * P2_KROW, P2_LN = 72 * 1024, P2_WM = 76 * 1024;

constexpr int RING_BYTES = 131072, LDS_BYTES = 147456, LDSCTL_OFF = LDS_BYTES - 1024, MISC_OFF = LDSCTL_OFF + 320;

typedef unsigned v2u __attribute__((ext_vector_type(2)));
typedef float f32x2 __attribute__((ext_vector_type(2)));
__device__ __forceinline__ float bf2f(unsigned h) { return __builtin_bit_cast(float, h << 16); }
__device__ __forceinline__ float bflo(unsigned w) { return __builtin_bit_cast(float, w << 16); }
__device__ __forceinline__ float bfhi(unsigned w) { return __builtin_bit_cast(float, w & 0xffff0000u); }
__device__ __forceinline__ float wave_sum(float v) {
#pragma unroll
    for (int o = 1; o < 64; o <<= 1) v += __shfl_xor(v, o);
    return v;
}
__device__ __forceinline__ float wave_max(float v) {
#pragma unroll
    for (int o = 1; o < 64; o <<= 1) v = fmaxf(v, __shfl_xor(v, o));
    return v;
}
constexpr double FX_SSQ = 1048576.0, FX_ZST = 4294967296.0;
__device__ __forceinline__ unsigned long long fx_enc(float v, double scale) { return (unsigned long long)(long long)((double)v * scale); }
__device__ __forceinline__ void fx_add(unsigned long long* p, float v, double scale) { __hip_atomic_fetch_add(p, fx_enc(v, scale), __ATOMIC_RELAXED, __HIP_MEMORY_SCOPE_AGENT); }
__device__ __forceinline__ float rstd_from_ssq(const unsigned long long* p) { const unsigned long long v = *p; const float f = (float)(unsigned)(v >> 32) * 4294967296.0f + (float)(unsigned)v;
    return __builtin_amdgcn_rsqf(f * (float)(1.0 / (FX_SSQ * 2048.0)) + 1e-5f); }
__device__ __forceinline__ float sigmoidf_(float x) { return __builtin_amdgcn_rcpf(1.0f + __builtin_amdgcn_exp2f(-1.4426950408889634f * x)); }

__device__ __forceinline__ size_t blk_idx(size_t r, int c, int cols) { return ((r >> 7) * (size_t)(cols >> 6) + (size_t)(c >> 6)) * 8192 + (size_t)(pg8::lds_byte((int)(r & 127), c & 63) >> 1); }
__device__ __forceinline__ unsigned epi_img_byte(int wr, int wc, int fr, int fq) { return (unsigned)((wc >> 1) * 16384 + (8 * wr + (wc & 1)) * 1024 + ((fr * 64 + 16 * fq) ^ ((fr >> 3) << 5))); }
struct rsrc_t { const char* p; };
__device__ __forceinline__ rsrc_t mk_rsrc(const void* p, size_t) { rsrc_t r; r.p = (const char*)p; return r; }
__device__ __forceinline__ v4u bld16(rsrc_t r, unsigned voff, unsigned soff) { const char* sb = r.p + soff; asm volatile("" : "+s"(sb)); return *(const GAS v4u*)((const GAS char*)sb + voff); }
__device__ __forceinline__ v2u bld8(rsrc_t r, unsigned voff, unsigned soff) { const char* sb = r.p + soff; asm volatile("" : "+s"(sb)); return *(const GAS v2u*)((const GAS char*)sb + voff); }
__device__ __forceinline__ void bst16nt(v4u v, rsrc_t r, unsigned voff, unsigned soff) { const char* sb = r.p + soff; asm volatile("" : "+s"(sb)); __builtin_nontemporal_store(v, (GAS v4u*)((GAS char*)sb + voff)); }
__device__ __forceinline__ void bst16(v4u v, rsrc_t r, unsigned voff, unsigned soff) { const char* sb = r.p + soff; asm volatile("" : "+s"(sb)); *(GAS v4u*)((GAS char*)sb + voff) = v; }
__device__ __forceinline__ float rstd_from_bits(v2u w) { const float f = (float)w.y * 4294967296.0f + (float)w.x; return __builtin_amdgcn_rsqf(f * (float)(1.0 / (FX_SSQ * 2048.0)) + 1e-5f); }
namespace pg8 {
typedef __bf16 bf16x2_t __attribute__((ext_vector_type(2)));
__device__ __forceinline__ unsigned cvtpk(float lo, float hi) { const f32x2 v = {lo, hi}; return __builtin_bit_cast(unsigned, __builtin_convertvector(v, bf16x2_t)); }
__device__ __forceinline__ v4u pack8(const f32x4 v0, const f32x4 v1) { v4u w; w.x = cvtpk(v0[0], v0[1]); w.y = cvtpk(v0[2], v0[3]); w.z = cvtpk(v1[0], v1[1]); w.w = cvtpk(v1[2], v1[3]); return w; }
#define PIN2(a, b) asm volatile("" : "+v"(a), "+v"(b))
__device__ __forceinline__ f32x4 unlo(const v4u w) { return (f32x4){bflo(w.x), bfhi(w.x), bflo(w.y), bfhi(w.y)}; }
__device__ __forceinline__ f32x4 unhi(const v4u w) { return (f32x4){bflo(w.z), bfhi(w.z), bflo(w.w), bfhi(w.w)}; }
struct EpiInProj {
    static constexpr bool PERM = true, AFTER_DRAIN = false; static constexpr int MID_T = 0; static constexpr bool BLOCKED = false;
    const unsigned long long* ssq; const float* bias; const float* cs; unsigned long long* zst; bf16_t *q, *k, *v, *z, *g;
    __device__ __forceinline__ void operator()(const f32x4 (&acc)[2][2][4][2], const Unit& u, int wr, int wc, int fr, int fq) const {
        const int colt = u.pn * BM;
        bf16_t* base; int ldc, cb, mode;
        if (colt < OFF_K) { base = q; ldc = AW; cb = colt; mode = 0; }
        else if (colt < OFF_V) { base = k; ldc = KVW; cb = colt - OFF_K; mode = 0; }
        else if (colt < OFF_Z) { base = v; ldc = KVW; cb = colt - OFF_V; mode = 0; }
        else if (colt < OFF_G) { base = z; ldc = 2 * SGUW; cb = colt - OFF_Z; mode = 1; }
        else { base = g; ldc = DM; cb = (colt - OFF_G) >> 1; mode = 2; }
        const bool rope = (colt < OFF_V) && ((wc & 1) == 0);
        const bool vstat = (mode == 1) && (cb >= SGUW);
        const rsrc_t ro = mk_rsrc(base, (size_t)M * ldc * (mode == 2 ? 4 : 2)), rq = mk_rsrc(ssq, (size_t)M * 8), rc = mk_rsrc(cs, (size_t)M * 64);
        const unsigned lrow = wr * 64 + fr, vo = (lrow * ldc + wc * 32 + 8 * fq) * 2u, vq = lrow * 8u, vc = lrow * 64u;
        const unsigned so = ((unsigned)u.pm * BM * ldc + cb) * 2u, sq = (unsigned)u.pm * BM * 8u, sc = (unsigned)u.pm * BM * 64u;
        const int bcol0 = (mode == 2 ? OFF_G + cb : colt) + wc * 32 + 8 * fq;
        f32x4 bv[2][2];
#pragma unroll
        for (int bj = 0; bj < 2; ++bj)
#pragma unroll
            for (int n = 0; n < 2; ++n) bv[bj][n] = *(const f32x4*)(bias + bcol0 + bj * (mode == 2 ? DM : HALF) + 4 * n);
        v2u sw[2][4];
#pragma unroll
        for (int ai = 0; ai < 2; ++ai)
#pragma unroll
            for (int m = 0; m < 4; ++m) sw[ai][m] = bld8(rq, vq, sq + (ai * HALF + m * 16) * 8u);
#pragma unroll
        for (int ai = 0; ai < 2; ++ai)
#pragma unroll
            for (int m = 0; m < 4; ++m) { const unsigned rofs = (ai * HALF + m * 16); const float rs = rstd_from_bits(sw[ai][m]);
                if (mode == 2) {
                    const float c1 = rs * -1.4426950408889634f; f32x4 rv[2], sv[2];
#pragma unroll
                    for (int n = 0; n < 2; ++n) {
                        f32x4 ea = acc[ai][0][m][n] * c1 + bv[0][n] * -1.4426950408889634f, eb = acc[ai][1][m][n] * c1 + bv[1][n] * -1.4426950408889634f;
#pragma unroll
                        for (int j = 0; j < 4; ++j) { ea[j] = fminf(ea[j], 80.f); eb[j] = fminf(eb[j], 80.f); }
                        PIN2(ea, eb);
#pragma unroll
                        for (int j = 0; j < 4; ++j) { ea[j] = __builtin_amdgcn_exp2f(ea[j]); eb[j] = __builtin_amdgcn_exp2f(eb[j]); }
                        ea += 1.0f; eb += 1.0f; PIN2(ea, eb);
                        f32x4 ra, rb;
#pragma unroll
                        for (int j = 0; j < 4; ++j) { ra[j] = __builtin_amdgcn_rcpf(ea[j]); rb[j] = __builtin_amdgcn_rcpf(eb[j]); }
                        PIN2(ra, rb);
                        rv[n] = eb * ra; sv[n] = rb; }
                    {
                        const unsigned vg = (unsigned)(((wr * 4 + wc) * 64 + fq * 16 + fr) * 16), sg = ((((unsigned)u.pm * 16u + (unsigned)(cb >> 7)) * 2u + ai) * 4u + m) * 8192u;
                        bst16(pack8(rv[0], rv[1]), ro, vg, sg); bst16(pack8(sv[0], sv[1]), ro, vg, sg + (unsigned)((size_t)M * DM * 2)); }
                    continue; }
                f32x4 c0, c1, s0, s1;
                if (rope) { c0 = __builtin_bit_cast(f32x4, bld16(rc, vc, sc + rofs * 64u)); c1 = __builtin_bit_cast(f32x4, bld16(rc, vc, sc + rofs * 64u + 16u)); s0 = __builtin_bit_cast(f32x4, bld16(rc, vc, sc + rofs * 64u + 32u)); s1 = __builtin_bit_cast(f32x4, bld16(rc, vc, sc + rofs * 64u + 48u));
                    if (fq == 0) { s0 = -s0; s1 = -s1; } }
                float z1 = 0.f, z2 = 0.f;
#pragma unroll
                for (int bj = 0; bj < 2; ++bj) { f32x4 v0 = acc[ai][bj][m][0] * rs + bv[bj][0], v1 = acc[ai][bj][m][1] * rs + bv[bj][1];
                    if (rope) { f32x4 p0, p1;
#pragma unroll
                        for (int j = 0; j < 4; ++j) { p0[j] = __shfl_xor(v0[j], 16); p1[j] = __shfl_xor(v1[j], 16); }
                        if (fq < 2) { v0 = v0 * c0 + p0 * s0; v1 = v1 * c1 + p1 * s1; } }
                    if (mode == 1) { f32x2 a = gelu_pk((f32x2){v0[0], v0[1]}), b = gelu_pk((f32x2){v0[2], v0[3]}), c = gelu_pk((f32x2){v1[0], v1[1]}), d = gelu_pk((f32x2){v1[2], v1[3]});
                        v0 = (f32x4){a.x, a.y, b.x, b.y}; v1 = (f32x4){c.x, c.y, d.x, d.y};
                        if (vstat) { z1 += (v0[0] + v0[1]) + (v0[2] + v0[3]) + (v1[0] + v1[1]) + (v1[2] + v1[3]);
                            z2 += (v0[0] * v0[0] + v0[1] * v0[1]) + (v0[2] * v0[2] + v0[3] * v0[3]) + (v1[0] * v1[0] + v1[1] * v1[1]) + (v1[2] * v1[2] + v1[3] * v1[3]); } }
                    bst16(pack8(v0, v1), ro, vo, so + (rofs * ldc + bj * HALF) * 2u); }
                if (vstat) { z1 += __shfl_xor(z1, 16); z1 += __shfl_xor(z1, 32); z2 += __shfl_xor(z2, 16); z2 += __shfl_xor(z2, 32);
                    const size_t r = (size_t)u.pm * BM + lrow + rofs;
                    if (fq == 0) { fx_add(zst + r * 2, z1, FX_ZST); fx_add(zst + r * 2 + 1, z2, FX_ZST); } } }
    }
};
struct EpiGate {
    static constexpr bool PERM = true, AFTER_DRAIN = false; static constexpr int MID_T = AW / BK; static constexpr bool BLOCKED = false;
    const bf16_t* gr; const bf16_t* gs; bf16_t* mg;
    __device__ __forceinline__ void mid(f32x4 (&acc)[2][2][4][2], const Unit& u, int wr, int wc, int fr, int fq) const {
        const rsrc_t rg = mk_rsrc(gr, (size_t)M * DM * 2);
        const unsigned vg = (unsigned)(((wr * 4 + wc) * 64 + fq * 16 + fr) * 16);
        const unsigned vo = ((wr * 64 + fr) * DM + wc * 32 + 8 * fq) * 2u, so = ((unsigned)u.pm * BM * DM + (unsigned)u.pn * BM) * 2u;
#pragma unroll
        for (int ai = 0; ai < 2; ++ai) { v4u gw[4][2];
#pragma unroll
            for (int m = 0; m < 4; ++m)
#pragma unroll
                for (int bj = 0; bj < 2; ++bj) gw[m][bj] = bld16(rg, vg, ((((unsigned)u.pm * 16u + 2u * (unsigned)u.pn + bj) * 2u + ai) * 4u + m) * 8192u);
#pragma unroll
            for (int m = 0; m < 4; ++m)
#pragma unroll
                for (int bj = 0; bj < 2; ++bj) { acc[ai][bj][m][0] *= unlo(gw[m][bj]); acc[ai][bj][m][1] *= unhi(gw[m][bj]); } }
    }
    __device__ __forceinline__ void operator()(const f32x4 (&acc)[2][2][4][2], const Unit& u, int wr, int wc, int fr, int fq) const {
        const rsrc_t rg = mk_rsrc(gs, (size_t)M * DM * 2), ro = mk_rsrc(mg, (size_t)M * DM * 2);
        const unsigned vg = (unsigned)(((wr * 4 + wc) * 64 + fq * 16 + fr) * 16);
        const unsigned vo = ((wr * 64 + fr) * DM + wc * 32 + 8 * fq) * 2u, so = ((unsigned)u.pm * BM * DM + (unsigned)u.pn * BM) * 2u;
        const unsigned vb_ = epi_img_byte(wr, wc, fr, fq) >> 1, sb_ = ((unsigned)u.pm * 2u * (DM / 64) + (unsigned)u.pn * 4u) * 8192u;
        v4u gw[2][4][2];
#pragma unroll
        for (int ai = 0; ai < 2; ++ai)
#pragma unroll
            for (int m = 0; m < 4; ++m)
#pragma unroll
                for (int bj = 0; bj < 2; ++bj) gw[ai][m][bj] = bld16(rg, vg, ((((unsigned)u.pm * 16u + 2u * (unsigned)u.pn + bj) * 2u + ai) * 4u + m) * 8192u);
#pragma unroll
        for (int ai = 0; ai < 2; ++ai)
#pragma unroll
            for (int m = 0; m < 4; ++m)
#pragma unroll
                for (int bj = 0; bj < 2; ++bj) bst16(pack8(acc[ai][bj][m][0] * unlo(gw[ai][m][bj]), acc[ai][bj][m][1] * unhi(gw[ai][m][bj])), ro, vb_ * 2u, (sb_ + ((unsigned)ai * (DM / 64) + 2u * bj) * 8192u + m * 1024u) * 2u);
    }
};
struct EpiResid {
    static constexpr bool PERM = true, AFTER_DRAIN = false; static constexpr int MID_T = 0; static constexpr bool BLOCKED = true;
    float* hout; bf16_t* hb; unsigned long long* ssq_out;
    __device__ __forceinline__ void operator()(const f32x4 (&acc)[2][2][4][2], const Unit& u, int wr, int wc, int fr, int fq) const {
        const rsrc_t rh = mk_rsrc(hout, 0), rb = mk_rsrc(hb, 0);
        const unsigned lrow = wr * 64 + fr, ve = lrow * DM + wc * 32 + 8 * fq, se = (unsigned)u.pm * BM * DM + (unsigned)u.pn * BM;
        const unsigned vb_ = epi_img_byte(wr, wc, fr, fq) >> 1, sb_ = ((unsigned)u.pm * 2u * (DM / 64) + (unsigned)u.pn * 4u) * 8192u;
        const bool out32 = hout != nullptr;
        v4u tb[2][4][2];
#pragma unroll
        for (int ai = 0; ai < 2; ++ai)
#pragma unroll
            for (int m = 0; m < 4; ++m)
#pragma unroll
                for (int bj = 0; bj < 2; ++bj) tb[ai][m][bj] = bld16(rb, vb_ * 2u, (sb_ + ((unsigned)ai * (DM / 64) + 2u * bj) * 8192u + m * 1024u) * 2u);
#pragma unroll
        for (int ai = 0; ai < 2; ++ai)
#pragma unroll
            for (int m = 0; m < 4; ++m) { float sq = 0.f;
#pragma unroll
                for (int bj = 0; bj < 2; ++bj) { const unsigned e = se + (ai * HALF + m * 16) * DM + bj * HALF, eb = sb_ + ((unsigned)ai * (DM / 64) + 2u * bj) * 8192u + m * 1024u;
                    const f32x4 v0 = acc[ai][bj][m][0] + unlo(tb[ai][m][bj]), v1 = acc[ai][bj][m][1] + unhi(tb[ai][m][bj]);
                    if (out32) { bst16(__builtin_bit_cast(v4u, v0), rh, ve * 4u, e * 4u); bst16(__builtin_bit_cast(v4u, v1), rh, ve * 4u, e * 4u + 16u); }
                    sq += (v0[0] * v0[0] + v0[1] * v0[1]) + (v0[2] * v0[2] + v0[3] * v0[3]) + (v1[0] * v1[0] + v1[1] * v1[1]) + (v1[2] * v1[2] + v1[3] * v1[3]);
                    bst16(pack8(v0, v1), rb, vb_ * 2u, eb * 2u); }
                sq += __shfl_xor(sq, 16); sq += __shfl_xor(sq, 32);
                if (fq == 0) fx_add(ssq_out + (size_t)u.pm * BM + lrow + ai * HALF + m * 16, sq, FX_SSQ); }
    }
};
struct EpiSwiglu {
    static constexpr bool PERM = true, AFTER_DRAIN = false; static constexpr int MID_T = 0; static constexpr bool BLOCKED = false;
    const unsigned long long* ssq; bf16_t* act;
    __device__ __forceinline__ void operator()(const f32x4 (&acc)[2][2][4][2], const Unit& u, int wr, int wc, int fr, int fq) const {
        const rsrc_t ro = mk_rsrc(act, (size_t)M * DFF * 2), rq = mk_rsrc(ssq, (size_t)M * 8);
        const unsigned lrow = wr * 64 + fr, vo = epi_img_byte(wr, wc, fr, fq), so = (((unsigned)u.pm * 2u * (DFF / 64) + (unsigned)u.pn * 2u) * 8192u) * 2u, vq = lrow * 8u, sq = (unsigned)u.pm * BM * 8u;
        v2u sw[2][4];
#pragma unroll
        for (int ai = 0; ai < 2; ++ai)
#pragma unroll
            for (int m = 0; m < 4; ++m) sw[ai][m] = bld8(rq, vq, sq + (ai * HALF + m * 16) * 8u);
#pragma unroll
        for (int ai = 0; ai < 2; ++ai)
#pragma unroll
            for (int m = 0; m < 4; ++m) { const float rs = rstd_from_bits(sw[ai][m]); const float c1 = rs * -1.4426950408889634f, rs2 = rs * rs;
                const f32x4 a0 = acc[ai][0][m][0], a1 = acc[ai][0][m][1];
                f32x4 e0 = a0 * c1, e1 = a1 * c1; PIN2(e0, e1);
#pragma unroll
                for (int j = 0; j < 4; ++j) { e0[j] = __builtin_amdgcn_exp2f(e0[j]); e1[j] = __builtin_amdgcn_exp2f(e1[j]); }
                f32x4 p0 = a0 * acc[ai][1][m][0], p1 = a1 * acc[ai][1][m][1]; p0 *= rs2; p1 *= rs2;
                e0 += 1.0f; e1 += 1.0f; PIN2(e0, e1);
#pragma unroll
                for (int j = 0; j < 4; ++j) { e0[j] = __builtin_amdgcn_rcpf(e0[j]); e1[j] = __builtin_amdgcn_rcpf(e1[j]); }
                PIN2(e0, e1);
                bst16nt(pack8(p0 * e0, p1 * e1), ro, vo, so + ((unsigned)ai * (DFF / 64) * 8192u + m * 16 * 64u) * 2u); }
    }
};
}

struct Frame {
    LAS unsigned char* lds; volatile LAS unsigned* MISC; gu32* ctl;
    int tid, lane, wave, vcu, G;
};
struct Args { const void* in[17]; float* out; unsigned char* ws; int ph_lo, ph_hi, li, pad; };
enum { I_X = 0, I_POS, I_N1G, I_WIN, I_BIN, I_SINKS, I_LNG, I_LNB, I_SGUW, I_SGUB, I_WAB, I_WSB, I_WOUT, I_N2G, I_WGU, I_WDN, I_FG };

constexpr int TP_PITCH = 272, TP_SCR_BYTES = 32 * TP_PITCH;
typedef short s16x4_t __attribute__((ext_vector_type(4)));
__device__ __forceinline__ void transpose_item(const float* W, int K, int N, bf16* WT, int ldk, int koff, const float* gain, int mode, LAS float* scr_, int item, int lane) {
    LAS unsigned char* scr = (LAS unsigned char*)scr_;
    const int nblk = N / 128, kb = item / nblk, nb = item % nblk, k0 = 32 * kb, n0 = 128 * nb;
    const int kr = lane >> 5, n4 = lane & 31;
    const float* src = W + (size_t)(k0 + kr) * N + n0 + 4 * n4;
    f32x4 v[16];
#pragma unroll
    for (int i = 0; i < 16; ++i) v[i] = __builtin_nontemporal_load((const f32x4*)(src + (size_t)(2 * i) * N));
    if (gain) {
#pragma unroll
        for (int i = 0; i < 16; ++i) v[i] *= gain[k0 + 2 * i + kr]; }
#pragma unroll
    for (int i = 0; i < 16; ++i) *(LAS v2u*)(scr + (2 * i + kr) * TP_PITCH + 8 * n4) = (v2u){pg8::cvtpk(v[i][0], v[i][1]), pg8::cvtpk(v[i][2], v[i][3])};
    LDS_WAIT(); asm volatile("" ::: "memory");
    int d0 = n0;
    if (mode == 1) { const int bj = n0 / DFF, rem = n0 % DFF; d0 = 256 * (rem / 128) + 128 * bj; }
    if (mode == 2 && n0 >= OFF_G) { const int rel = n0 - OFF_G, bj = rel / DM, rem = rel % DM; d0 = OFF_G + 256 * (rem / 128) + 128 * bj; }
    GAS unsigned char* dst = (GAS unsigned char*)(WT + ((size_t)(d0 >> 7) * (ldk / 64) + (koff + k0) / 64) * 8192) + (((koff + k0) >> 5) & 1) * 1024;
    const int fr = lane & 15, fq = lane >> 4, q = fr >> 2, p = fr & 3;
    const unsigned ob = (unsigned)((fr * 64 + fq * 16) ^ ((fr >> 3) << 5));
#pragma unroll
    for (int G = 0; G < 8; ++G) {
        const LAS unsigned char* tp = scr + (8 * fq + q) * TP_PITCH + (32 * (G >> 1) + 8 * p + 4 * (G & 1)) * 2;
        const s16x4_t lo = __builtin_amdgcn_ds_read_tr16_b64_v4i16((LAS s16x4_t*)tp), hi = __builtin_amdgcn_ds_read_tr16_b64_v4i16((LAS s16x4_t*)(tp + 4 * TP_PITCH));
        const v2u l2 = __builtin_bit_cast(v2u, lo), h2 = __builtin_bit_cast(v2u, hi);
        *(GAS v4u*)(dst + G * 2048 + ob) = (v4u){l2.x, l2.y, h2.x, h2.y}; }
    LDS_WAIT(); asm volatile("" ::: "memory");
}
__device__ __forceinline__ void sincos_red(float ang, float& c, float& s) {
    const double a = (double)ang; const double kq = __builtin_rint(a * 0.63661977236758134308);
    const double r = __builtin_fma(-kq, 1.57079632679489661923, a) - kq * 6.123233995736766e-17; const double r2 = r * r;
    double sp = -2.5052108385441718775e-8; sp = sp * r2 + 2.7557319223985890653e-6; sp = sp * r2 - 1.9841269841269841253e-4; sp = sp * r2 + 8.3333333333333332177e-3; sp = sp * r2 - 1.6666666666666665741e-1; sp = r + r * r2 * sp;
    double cp = 2.0876756987868098979e-9; cp = cp * r2 - 2.7557319223985890653e-7; cp = cp * r2 + 2.4801587301587301566e-5; cp = cp * r2 - 1.3888888888888889419e-3; cp = cp * r2 + 4.1666666666666664354e-2; cp = cp * r2 - 0.5; cp = 1.0 + r2 * cp;
    const int qd = ((int)(long long)kq) & 3;
    const double cs = (qd & 1) ? sp : cp, sn = (qd & 1) ? cp : sp;
    c = (float)((qd == 1 || qd == 2) ? -cs : cs); s = (float)((qd >= 2) ? -sn : sn);
}

constexpr int CI_IN = (DM / 64) * (INW / 64), CI_AB = (AW / 64) * (DM / 64), CI_SB = (SGUW / 64) * (DM / 64), CI_OUT = (DM / 64) * (DM / 64), CI_GU = (DM / 64) * (2 * DFF / 64), CI_DN = (DFF / 64) * (DM / 64);
constexpr int CI_LAYER = CI_IN + CI_AB + CI_SB + CI_OUT + CI_GU + CI_DN;
constexpr int CI_IDLE_PER_WAVE = 5;
__device__ __forceinline__ void convert_item(const Args& args, unsigned char* ws, int l, int r, LAS float* scr, int lane) {
    unsigned char* wl = ws + WS_W + (size_t)l * W_LAYER;
    const float* W; int K, N, ldk, koff = 0, mode = 0; bf16* WT; const float* gain = nullptr;
    if (r < CI_IN) { W = (const float*)args.in[I_WIN] + (size_t)l * DM * INW; K = DM; N = INW; WT = (bf16*)(wl + WL_IN); ldk = DM; gain = (const float*)args.in[I_N1G] + l * DM; mode = 2; }
    else if ((r -= CI_IN) < CI_AB) { W = (const float*)args.in[I_WAB] + (size_t)l * AW * DM; K = AW; N = DM; WT = (bf16*)(wl + WL_AB); ldk = DM; }
    else if ((r -= CI_AB) < CI_SB) { W = (const float*)args.in[I_WSB] + (size_t)l * SGUW * DM; K = SGUW; N = DM; WT = (bf16*)(wl + WL_AB); ldk = DM; koff = AW; }
    else if ((r -= CI_SB) < CI_OUT) { W = (const float*)args.in[I_WOUT] + (size_t)l * DM * DM; K = DM; N = DM; WT = (bf16*)(wl + WL_OUT); ldk = DM; }
    else if ((r -= CI_OUT) < CI_GU) { W = (const float*)args.in[I_WGU] + (size_t)l * DM * 2 * DFF; K = DM; N = 2 * DFF; WT = (bf16*)(wl + WL_GU); ldk = DM; gain = (const float*)args.in[I_N2G] + l * DM; mode = 1; }
    else { r -= CI_GU; W = (const float*)args.in[I_WDN] + (size_t)l * DFF * DM; K = DFF; N = DM; WT = (bf16*)(wl + WL_DN); ldk = DFF; }
    transpose_item(W, K, N, WT, ldk, koff, gain, mode, scr, r, lane);
}

constexpr int NPL = 6;
constexpr int N_PHASES = 1 + DEPTH * NPL + 1;

__global__ void __launch_bounds__(NWAVES * 64, 2) fwd(Args args) {
    extern __shared__ __attribute__((aligned(16))) unsigned char lds[];
    Frame F;
    F.lds = (LAS unsigned char*)lds; F.MISC = (volatile LAS unsigned*)(F.lds + MISC_OFF);
    F.tid = threadIdx.x; F.lane = F.tid & 63; F.wave = __builtin_amdgcn_readfirstlane(F.tid >> 6);
    F.G = gridDim.x; { const int bx = blockIdx.x; F.vcu = (F.G % 8 == 0) ? (bx % 8) * (F.G / 8) + bx / 8 : bx; }
    unsigned char* ws = args.ws;
    F.ctl = (gu32*)(ws + WS_CTL);
    for (int u = F.tid; u < (LDS_BYTES - LDSCTL_OFF) / 4; u += NWAVES * 64) ((LAS unsigned*)(F.lds + LDSCTL_OFF))[u] = 0u;
    __syncthreads();
    const int lo = args.ph_lo, hi = args.ph_hi;
    const bool use_bar = (hi - lo) > 1;
    XcdBarrier bar; bar.bar = (unsigned*)(F.ctl + CW_BAR); bar.x = 0; bar.st = nullptr;
    if (use_bar) bar = xcd_barrier_post((unsigned*)(F.ctl + CW_BAR), F.MISC + 8);
    if (use_bar && F.tid == 0) __hip_atomic_store((unsigned*)(F.ctl + CW_XTAB) + blockIdx.x, 1u + xb_xcc_id(), __ATOMIC_RELAXED, __HIP_MEMORY_SCOPE_AGENT);
    bool xl_ok = false;
#define PH_IN(id) (lo <= (id) && (id) < hi)
#define PH_END(id) do { if ((id) + 1 < hi) xcd_barrier(bar, F.wave == 0); } while (0)
#define PH_END_LOCAL(id) do { if ((id) + 1 < hi) { if (xl_ok) xcc_local_barrier((unsigned*)(F.ctl + CW_XL) + 64 * (blockIdx.x & 7), F.MISC + 11, (unsigned)(F.G >> 3), F.wave == 0); else xcd_barrier(bar, F.wave == 0); } } while (0)

    const float* x = (const float*)args.in[I_X]; const int* pos = (const int*)args.in[I_POS];
    float* h = args.out;
    bf16* hb = (bf16*)(ws + WS_HB); bf16* qb = (bf16*)(ws + WS_Q); bf16* kb = (bf16*)(ws + WS_K); bf16* vb = (bf16*)(ws + WS_V);
    bf16* zb = (bf16*)(ws + WS_Z); bf16* gb = (bf16*)(ws + WS_G); bf16* yb = (bf16*)(ws + WS_Y); bf16* mgb = (bf16*)(ws + WS_MG);
    bf16* actb = (bf16*)(ws + WS_ACT); float* tb = (float*)(ws + WS_T);
    float* cs = (float*)(ws + WS_CS); unsigned long long* ssq = (unsigned long long*)(ws + WS_SSQ); unsigned long long* zst = (unsigned long long*)(ws + WS_ZST);
    const int gw = F.vcu * NWAVES + F.wave, NGW = F.G * NWAVES, lane = F.lane;

    if (PH_IN(0)) {
        LAS float* scr = (LAS float*)(F.lds + F.wave * TP_SCR_BYTES);
        const int nwg_in = (M / 256) * (INW / 256), nrounds_in = (nwg_in + F.G - 1) / F.G, n_idle_wg = nrounds_in * F.G - nwg_in, nconv = n_idle_wg > 0 ? (n_idle_wg * NWAVES * CI_IDLE_PER_WAVE < CI_LAYER ? n_idle_wg * NWAVES * CI_IDLE_PER_WAVE : CI_LAYER) : 0;
        const int nrem = CI_LAYER - nconv;
        for (int it = gw; it < DEPTH * nrem; it += NGW) { const int l = DEPTH - 1 - it / nrem, r = nrem - 1 - it % nrem; convert_item(args, ws, l, r, scr, lane); }
        for (int m0 = gw; m0 < M; m0 += 2 * NGW) {
            f32x4 xv[2][8];
#pragma unroll
            for (int r2 = 0; r2 < 2; ++r2) { const int m = (m0 + r2 * NGW < M) ? m0 + r2 * NGW : m0; const GAS f32x4* xr = (const GAS f32x4*)(x + (size_t)m * DM) + lane;
#pragma unroll
                for (int j = 0; j < 8; ++j) xv[r2][j] = __builtin_nontemporal_load(xr + 64 * j); }
#pragma unroll
            for (int r2 = 0; r2 < 2; ++r2) { const int m = m0 + r2 * NGW; if (m < M) {
                GAS v2u* br = (GAS v2u*)(hb + ((size_t)(m >> 7) * (DM / 64) + (lane >> 4)) * 8192 + (pg8::lds_byte(m & 127, 4 * (lane & 15)) >> 1));
                float sq = 0.f;
#pragma unroll
                for (int j = 0; j < 8; ++j) { const f32x4 v = xv[r2][j]; br[(size_t)j * 4 * 8192 / 4] = (v2u){pk2(v.x, v.y), pk2(v.z, v.w)}; sq += (v.x * v.x + v.y * v.y) + (v.z * v.z + v.w * v.w); }
                sq = wave_sum(sq); if (lane == 0) ssq[m] = fx_enc(sq, FX_SSQ); } }
        }
        for (int i = (blockIdx.x * NWAVES * 64 + F.tid); i < DEPTH * SGUG * CHUNK * CHUNK; i += F.G * NWAVES * 64) {
            const int sx = i & 127, t = (i >> 7) & 127; ((bf16*)(ws + WS_SGUWM))[i] = (sx <= t) ? (bf16)f2bf(((const float*)args.in[I_SGUW])[i]) : (bf16)0; }
        for (int i = (blockIdx.x * NWAVES * 64 + F.tid); i < M * 8; i += F.G * NWAVES * 64) {
            const int m = i >> 3, f = i & 7;
            const float invf[8] = {1.0f, 0.1939227432012558f, 0.03760603070259094f, 0.007292664609849453f, 0.0014142135623842478f, 0.00027424818836152554f, 5.318296098266728e-05f, 1.0313386155758053e-05f};
            float fr = invf[0];
#pragma unroll
            for (int q = 1; q < 8; ++q) fr = (f == q) ? invf[q] : fr;
            const float ang = (float)pos[m] * fr; float c, s; sincos_red(ang, c, s);
            cs[m * 16 + f] = c; cs[m * 16 + 8 + f] = s;
        }
        PH_END(0);
        if (use_bar && lo == 0 && hi == N_PHASES && F.G == 256) {
            int bad = 0;
            for (int j = F.tid; j < F.G; j += NWAVES * 64) { const unsigned v = __hip_atomic_load((unsigned*)(F.ctl + CW_XTAB) + j, __ATOMIC_RELAXED, __HIP_MEMORY_SCOPE_AGENT), r = __hip_atomic_load((unsigned*)(F.ctl + CW_XTAB) + (j & 7), __ATOMIC_RELAXED, __HIP_MEMORY_SCOPE_AGENT); bad |= (v == 0u || v != r) ? 1 : 0; }
            xl_ok = !__syncthreads_or(bad);
        }
    }

    for (int l = 0; l < DEPTH; ++l) {
        const int pb = 1 + l * NPL;
        int tid_l = lane_here() + 64 * F.wave; asm volatile("" : "+v"(tid_l));
        const int lane = tid_l & 63, tidl = tid_l;
        unsigned char* wl = ws + WS_W + (size_t)l * W_LAYER;
        if (PH_IN(pb + 0)) {
            pg8::Gemm g{hb, (const bf16*)(wl + WL_IN), M, INW, DM}; pg8::StaticOrder S; S.init(M, INW, F.G, (int)blockIdx.x, 4);
            pg8::EpiInProj E{ssq + (size_t)(2 * l) * M, (const float*)args.in[I_BIN] + l * INW, cs, zst + (size_t)l * M * 2, qb, kb, vb, zb, gb};
            pg8::gemm_phase<pg8::EpiInProj, pg8::StaticOrder, true, true>(F.lds, g, S, E, F.wave);
            {
                const int nwg_in = (M / 256) * (INW / 256), nrounds_in = (nwg_in + F.G - 1) / F.G, n_idle_wg = nrounds_in * F.G - nwg_in, rank = (nrounds_in - 1) * F.G + (int)blockIdx.x - nwg_in;
                if (n_idle_wg > 0 && rank >= 0 && rank < n_idle_wg) {
                    LAS float* scr = (LAS float*)(F.lds + F.wave * TP_SCR_BYTES);
                    const int nconv = n_idle_wg * NWAVES * CI_IDLE_PER_WAVE < CI_LAYER ? n_idle_wg * NWAVES * CI_IDLE_PER_WAVE : CI_LAYER;
                    for (int k = 0; k < CI_IDLE_PER_WAVE; ++k) { const int r = CI_LAYER - nconv + (rank * NWAVES + F.wave) + k * n_idle_wg * NWAVES; if (r < CI_LAYER) convert_item(args, ws, l, r, scr, lane); } } }
            PH_END(pb + 0);
        }
        if (PH_IN(pb + 1)) {
            typedef short s16x8 __attribute__((ext_vector_type(8)));
            typedef float f32x16 __attribute__((ext_vector_type(16)));
            const int q_ = lane & 31, hh = lane >> 5, wave = F.wave;
            const float* sinks = (const float*)args.in[I_SINKS] + l * NQH;
            const int cls_ = (int)blockIdx.x & 7, crank_ = (int)blockIdx.x >> 3;
            for (int ka = 0; ; ++ka) { const int ua = xl_ok ? 64 * cls_ + crank_ + 32 * ka : F.vcu + F.G * ka; if (ua >= (M / 128) * NKVH || (xl_ok && ka >= 2)) break;
                const int hk = ua & 3, blk = ua >> 2, nb = blk & 63, b = blk >> 6;
                const size_t row0 = (size_t)b * SEQ + (size_t)nb * 128;
                s16x8 qfa[2][4];
#pragma unroll
                for (int gi = 0; gi < 2; ++gi)
#pragma unroll
                    for (int ks = 0; ks < 4; ++ks) qfa[gi][ks] = *(const GAS s16x8*)(qb + (row0 + 32 * ((wave & 1) * 2 + gi) + q_) * AW + (hk * 4 + (wave >> 1)) * HD + 16 * ks + 8 * hh);
                LDS_WAIT(); __builtin_amdgcn_s_barrier(); asm volatile("" ::: "memory");
#pragma unroll
                for (int p = 0; p < 4; ++p) { const int chunk = p * 512 + tidl, kx = chunk >> 3, dc = chunk & 7; const bool ok = (nb > 0) || (kx >= 128);
                    v4u kv = (v4u){0u, 0u, 0u, 0u}; if (ok) kv = *(const GAS v4u*)(kb + (row0 + kx - 128) * KVW + hk * HD + dc * 8);
                    *(LAS v4u*)(F.lds + P2_K + kx * P2_KROW + dc * 16) = kv; }
#pragma unroll
                for (int p = 0; p < 4; ++p) { const int chunk = p * 512 + tidl, dc = chunk >> 8, kx = chunk & 255; const bool ok = (nb > 0) || (kx >= 128);
                    v4u vv = (v4u){0u, 0u, 0u, 0u}; if (ok) vv = *(const GAS v4u*)(vb + (row0 + kx - 128) * KVW + hk * HD + dc * 8);
                    const int pos = (kx & ~15) + 8 * ((kx >> 2) & 1) + 4 * ((kx >> 3) & 1) + (kx & 3);
                    LAS unsigned short* vp = (LAS unsigned short*)(F.lds + P2_V + (dc * 8) * P2_VROW + pos * 2);
                    vp[0 * (P2_VROW / 2)] = (unsigned short)(vv.x & 0xffffu); vp[1 * (P2_VROW / 2)] = (unsigned short)(vv.x >> 16);
                    vp[2 * (P2_VROW / 2)] = (unsigned short)(vv.y & 0xffffu); vp[3 * (P2_VROW / 2)] = (unsigned short)(vv.y >> 16);
                    vp[4 * (P2_VROW / 2)] = (unsigned short)(vv.z & 0xffffu); vp[5 * (P2_VROW / 2)] = (unsigned short)(vv.z >> 16);
                    vp[6 * (P2_VROW / 2)] = (unsigned short)(vv.w & 0xffffu); vp[7 * (P2_VROW / 2)] = (unsigned short)(vv.w >> 16); }
                LDS_WAIT(); __builtin_amdgcn_s_barrier(); asm volatile("" ::: "memory");
                const int hq = hk * 4 + (wave >> 1);
                const float sink2 = sinks[hq] * 1.4426950408889634f;
#pragma unroll
                for (int gi = 0; gi < 2; ++gi) {
                    const int tg = (wave & 1) * 2 + gi; const size_t trow = row0 + 32 * tg + q_;
                    s16x8 qf[4];
#pragma unroll
                    for (int ks = 0; ks < 4; ++ks) qf[ks] = qfa[gi][ks];
                    f32x16 st[5];
#pragma unroll
                    for (int jt = 0; jt < 5; ++jt) { const int kt = tg + jt; f32x16 a = {};
#pragma unroll
                        for (int ks = 0; ks < 4; ++ks) { const s16x8 kf = *(const LAS s16x8*)(F.lds + P2_K + (32 * kt + q_) * P2_KROW + (16 * ks + 8 * hh) * 2);
                            a = __builtin_amdgcn_mfma_f32_32x32x16_bf16(kf, qf[ks], a, 0, 0, 0); }
                        st[jt] = a; }
                    const float c2 = 0.125f * 1.4426950408889634f; const float NEGINF = -__builtin_inff();
                    float mx = sink2;
#pragma unroll
                    for (int jt = 0; jt < 5; ++jt) { const bool dead = (nb == 0) && (tg + jt < 4);
#pragma unroll
                        for (int r = 0; r < 16; ++r) { const int i = (r & 3) + 8 * (r >> 2) + 4 * hh; bool ok = !dead; if (jt == 0) ok = ok && (i > q_); if (jt == 4) ok = ok && (i <= q_);
                            const float v = ok ? st[jt][r] * c2 : NEGINF; st[jt][r] = v; mx = fmaxf(mx, v); } }
                    mx = fmaxf(mx, __shfl_xor(mx, 32));
                    float lsum = 0.f;
#pragma unroll
                    for (int jt = 0; jt < 5; ++jt)
#pragma unroll
                        for (int r = 0; r < 16; ++r) { const float pe = __builtin_amdgcn_exp2f(st[jt][r] - mx); st[jt][r] = pe; lsum += pe; }
                    lsum += __shfl_xor(lsum, 32); lsum += __builtin_amdgcn_exp2f(sink2 - mx);
                    f32x16 o0 = {}, o1 = {};
#pragma unroll
                    for (int jt = 0; jt < 5; ++jt) { const int kt = tg + jt;
#pragma unroll
                        for (int sp = 0; sp < 2; ++sp) {
                            v4u pw; pw.x = pg8::cvt_pk_bf16(st[jt][8 * sp + 0], st[jt][8 * sp + 1]); pw.y = pg8::cvt_pk_bf16(st[jt][8 * sp + 2], st[jt][8 * sp + 3]);
                            pw.z = pg8::cvt_pk_bf16(st[jt][8 * sp + 4], st[jt][8 * sp + 5]); pw.w = pg8::cvt_pk_bf16(st[jt][8 * sp + 6], st[jt][8 * sp + 7]);
                            const s16x8 pf = __builtin_bit_cast(s16x8, pw);
                            const s16x8 v0 = *(const LAS s16x8*)(F.lds + P2_V + (q_) * P2_VROW + (32 * kt + 16 * sp + 8 * hh) * 2);
                            const s16x8 v1 = *(const LAS s16x8*)(F.lds + P2_V + (32 + q_) * P2_VROW + (32 * kt + 16 * sp + 8 * hh) * 2);
                            o0 = __builtin_amdgcn_mfma_f32_32x32x16_bf16(v0, pf, o0, 0, 0, 0);
                            o1 = __builtin_amdgcn_mfma_f32_32x32x16_bf16(v1, pf, o1, 0, 0, 0); } }
                    const float inv = 1.0f / lsum;
#pragma unroll
                    for (int rq = 0; rq < 4; ++rq) {
                        *(GAS v2u*)(yb + blk_idx(trow, hq * HD + 4 * hh + 8 * rq, DM)) = (v2u){pg8::cvt_pk_bf16(o0[4 * rq + 0] * inv, o0[4 * rq + 1] * inv), pg8::cvt_pk_bf16(o0[4 * rq + 2] * inv, o0[4 * rq + 3] * inv)};
                        *(GAS v2u*)(yb + blk_idx(trow, hq * HD + 32 + 4 * hh + 8 * rq, DM)) = (v2u){pg8::cvt_pk_bf16(o1[4 * rq + 0] * inv, o1[4 * rq + 1] * inv), pg8::cvt_pk_bf16(o1[4 * rq + 2] * inv, o1[4 * rq + 3] * inv)}; }
                }
            }
            const float* lng = (const float*)args.in[I_LNG] + l * SGUW; const float* lnb = (const float*)args.in[I_LNB] + l * SGUW;
            const float* sbias = (const float*)args.in[I_SGUB] + l * SGUG * CHUNK;
            const bf16* wm_l = (const bf16*)(ws + WS_SGUWM) + (size_t)l * SGUG * CHUNK * CHUNK;
            bf16* ys = yb + AW;
            {
                constexpr int NU = (M / CHUNK) * SGUG;
                const int ct = wave & 3, tt0 = wave >> 2, tt1 = 3 - tt0;
                LAS float* lnp = (LAS float*)(F.lds + P2_LN);
                v4u zv[4], zs[4]; int gcur = -1;
                auto sgu_unit = [&](int k) -> int { const int u_ = xl_ok ? 128 * cls_ + crank_ + 32 * k : F.vcu + F.G * k; return (u_ < NU && (!xl_ok || k < 4)) ? u_ : -1; };
                int ks_ = 0, us = sgu_unit(0);
#define SGU_ISSUE(us_) do { const int g_ = (us_) & 7; const size_t base_ = (size_t)((us_) >> 3) * CHUNK; \
                    _Pragma("unroll") for (int p = 0; p < 4; ++p) { const int c = p * 512 + tidl, cc = c >> 7, sx = c & 127; \
                        zv[p] = *(const GAS v4u*)(zb + (base_ + sx) * (2 * SGUW) + SGUW + 128 * g_ + cc * 8); zs[p] = *(const GAS v4u*)(zst + ((size_t)l * M + base_ + sx) * 2); } } while (0)
                if (us >= 0) SGU_ISSUE(us);
                for (; us >= 0; us = sgu_unit(++ks_)) { const int usn = sgu_unit(ks_ + 1);
                    const int g = us & 7, chunk = us >> 3; const size_t base = (size_t)chunk * CHUNK;
                    v2u uw[2][4];
#pragma unroll
                    for (int ti = 0; ti < 2; ++ti)
#pragma unroll
                        for (int rq = 0; rq < 4; ++rq) uw[ti][rq] = *(const GAS v2u*)(zb + (base + 32 * (ti == 0 ? tt0 : tt1) + q_) * (2 * SGUW) + 128 * g + 32 * ct + 4 * hh + 8 * rq);
                    LDS_WAIT(); __builtin_amdgcn_s_barrier(); asm volatile("" ::: "memory");
                    if (g != gcur) {
                        gcur = g; const bf16* wm = wm_l + (size_t)g * CHUNK * CHUNK;
                        if (tidl < 256) lnp[tidl] = (tidl < 128) ? lng[128 * g + tidl] : lnb[128 * g + tidl - 128];
#pragma unroll
                        for (int p = 0; p < 4; ++p) { const int c = p * 512 + tidl, t = c >> 4, sc = c & 15;
                            *(LAS v4u*)(F.lds + P2_WM + t * P2_SROW + sc * 16) = *(const GAS v4u*)(wm + (size_t)t * CHUNK + sc * 8); }
                        LDS_WAIT(); __builtin_amdgcn_s_barrier(); asm volatile("" ::: "memory"); }
#pragma unroll
                    for (int p = 0; p < 4; ++p) { const int c = p * 512 + tidl, cc = c >> 7, sx = c & 127;
                        const unsigned long long z0 = (unsigned long long)zs[p].x | ((unsigned long long)zs[p].y << 32), z1 = (unsigned long long)zs[p].z | ((unsigned long long)zs[p].w << 32);
                        const double zm = (double)(long long)z0 * (1.0 / (FX_ZST * SGUW)); const double zvar = (double)(long long)z1 * (1.0 / (FX_ZST * SGUW)) - zm * zm; const float mm = (float)zm, rs = 1.0f / sqrtf((float)zvar + EPS);
                        const f32x4 g0 = *(const LAS f32x4*)(lnp + cc * 8), g1 = *(const LAS f32x4*)(lnp + cc * 8 + 4), b0 = *(const LAS f32x4*)(lnp + 128 + cc * 8), b1 = *(const LAS f32x4*)(lnp + 128 + cc * 8 + 4);
                        const v4u zw = zv[p];
                        LAS unsigned short* vp = (LAS unsigned short*)(F.lds + (cc * 8) * P2_SROW + sx * 2);
                        vp[0 * (P2_SROW / 2)] = (unsigned short)f2bf((bflo(zw.x) - mm) * rs * g0[0] + b0[0]); vp[1 * (P2_SROW / 2)] = (unsigned short)f2bf((bfhi(zw.x) - mm) * rs * g0[1] + b0[1]);
                        vp[2 * (P2_SROW / 2)] = (unsigned short)f2bf((bflo(zw.y) - mm) * rs * g0[2] + b0[2]); vp[3 * (P2_SROW / 2)] = (unsigned short)f2bf((bfhi(zw.y) - mm) * rs * g0[3] + b0[3]);
                        vp[4 * (P2_SROW / 2)] = (unsigned short)f2bf((bflo(zw.z) - mm) * rs * g1[0] + b1[0]); vp[5 * (P2_SROW / 2)] = (unsigned short)f2bf((bfhi(zw.z) - mm) * rs * g1[1] + b1[1]);
                        vp[6 * (P2_SROW / 2)] = (unsigned short)f2bf((bflo(zw.w) - mm) * rs * g1[2] + b1[2]); vp[7 * (P2_SROW / 2)] = (unsigned short)f2bf((bfhi(zw.w) - mm) * rs * g1[3] + b1[3]); }
                    if (usn >= 0) SGU_ISSUE(usn);
                    LDS_WAIT(); __builtin_amdgcn_s_barrier(); asm volatile("" ::: "memory");
                    f32x16 a0 = {}, a1 = {};
#pragma unroll
                    for (int sk = 0; sk < 8; ++sk) { const s16x8 af = *(const LAS s16x8*)(F.lds + (32 * ct + q_) * P2_SROW + (16 * sk + 8 * hh) * 2);
                        if (sk < 4) a0 = __builtin_amdgcn_mfma_f32_32x32x16_bf16(af, *(const LAS s16x8*)(F.lds + P2_WM + (32 * tt0 + q_) * P2_SROW + (16 * sk + 8 * hh) * 2), a0, 0, 0, 0);
                        a1 = __builtin_amdgcn_mfma_f32_32x32x16_bf16(af, *(const LAS s16x8*)(F.lds + P2_WM + (32 * tt1 + q_) * P2_SROW + (16 * sk + 8 * hh) * 2), a1, 0, 0, 0); }
#pragma unroll
                    for (int ti = 0; ti < 2; ++ti) { const int tt = ti == 0 ? tt0 : tt1; const f32x16 a = ti == 0 ? a0 : a1;
                        const int t = 32 * tt + q_; const size_t row = base + t; const float bs = sbias[g * CHUNK + t];
                        const int ch0 = 128 * g + 32 * ct + 4 * hh;
#pragma unroll
                        for (int rq = 0; rq < 4; ++rq) { const v2u u2 = uw[ti][rq];
                            *(GAS v2u*)(yb + blk_idx(row, AW + ch0 + 8 * rq, DM)) = (v2u){pg8::cvt_pk_bf16(bflo(u2.x) * (a[4 * rq + 0] + bs), bfhi(u2.x) * (a[4 * rq + 1] + bs)), pg8::cvt_pk_bf16(bflo(u2.y) * (a[4 * rq + 2] + bs), bfhi(u2.y) * (a[4 * rq + 3] + bs))}; } }
                }
#undef SGU_ISSUE
            }
            LDS_WAIT(); __builtin_amdgcn_s_barrier(); asm volatile("" ::: "memory");
            PH_END_LOCAL(pb + 1);
        }
        if (PH_IN(pb + 2)) {
            pg8::Gemm g{yb, (const bf16*)(wl + WL_AB), M, DM, DM}; pg8::StaticOrder S; S.init(M, DM, F.G, (int)blockIdx.x, 4);
            pg8::EpiGate E{gb, gb + (size_t)M * DM, mgb};
            pg8::gemm_phase<pg8::EpiGate, pg8::StaticOrder, true, true>(F.lds, g, S, E, F.wave);
            PH_END_LOCAL(pb + 2);
        }
        if (PH_IN(pb + 3)) {
            pg8::Gemm g{mgb, (const bf16*)(wl + WL_OUT), M, DM, DM}; pg8::StaticOrder S; S.init(M, DM, F.G, (int)blockIdx.x, 4);
            pg8::EpiResid E{nullptr, hb, ssq + (size_t)(2 * l + 1) * M};
            pg8::gemm_phase<pg8::EpiResid, pg8::StaticOrder, true, true>(F.lds, g, S, E, F.wave);
            PH_END_LOCAL(pb + 3);
        }
        if (PH_IN(pb + 4)) {
            pg8::Gemm g{hb, (const bf16*)(wl + WL_GU), M, 2 * DFF, DM}; pg8::StaticOrder S; S.init(M, 2 * DFF, F.G, (int)blockIdx.x, 4);
            pg8::EpiSwiglu E{ssq + (size_t)(2 * l + 1) * M, actb};
            pg8::gemm_phase<pg8::EpiSwiglu, pg8::StaticOrder, true, true>(F.lds, g, S, E, F.wave);
            PH_END_LOCAL(pb + 4);
        }
        if (PH_IN(pb + 5)) {
            pg8::Gemm g{actb, (const bf16*)(wl + WL_DN), M, DM, DFF}; pg8::StaticOrder S; S.init(M, DM, F.G, (int)blockIdx.x, 4);
            pg8::EpiResid E{nullptr, hb, ssq + (size_t)(2 * l + 2) * M};
            pg8::gemm_phase<pg8::EpiResid, pg8::StaticOrder, true, true>(F.lds, g, S, E, F.wave);
            PH_END_LOCAL(pb + 5);
        }
    }
    if (PH_IN(N_PHASES - 1)) {
        const float* fg = (const float*)args.in[I_FG];
        int lane_f = lane_here(); asm volatile("" : "+v"(lane_f));
        const int lane = lane_f;
        const int NGWF = F.G * NWAVES;
        const int fstart = xl_ok ? 2048 * ((int)blockIdx.x & 7) + ((int)blockIdx.x >> 3) * NWAVES + F.wave : F.vcu * NWAVES + F.wave, fstride = xl_ok ? 256 : NGWF;
        for (int m0 = fstart, fp = 0; m0 < M && (!xl_ok || fp < 4); m0 += 2 * fstride, ++fp) {
            v2u hw[2][8]; float rs[2];
#pragma unroll
            for (int r2 = 0; r2 < 2; ++r2) { const int m = (m0 + r2 * fstride < M) ? m0 + r2 * fstride : m0;
                const GAS v2u* br = (const GAS v2u*)(hb + ((size_t)(m >> 7) * (DM / 64) + (lane >> 4)) * 8192 + (pg8::lds_byte(m & 127, 4 * (lane & 15)) >> 1));
#pragma unroll
                for (int j = 0; j < 8; ++j) hw[r2][j] = br[(size_t)j * 8192];
                rs[r2] = rstd_from_ssq(ssq + (size_t)(2 * DEPTH) * M + m); }
            const GAS f32x4* gr = (const GAS f32x4*)fg + lane;
#pragma unroll
            for (int r2 = 0; r2 < 2; ++r2) { const int m = m0 + r2 * fstride; if (m < M) { GAS f32x4* orow = (GAS f32x4*)(h + (size_t)m * DM) + lane;
#pragma unroll
                for (int j = 0; j < 8; ++j) { const v2u w = hw[r2][j]; const f32x4 v = (f32x4){bflo(w.x), bfhi(w.x), bflo(w.y), bfhi(w.y)}; orow[64 * j] = v * rs[r2] * gr[64 * j]; } } } }
    }
#undef PH_IN
#undef PH_END
#undef PH_END_LOCAL
}

extern "C" void kernel_launch(void* const* d_in, const int* in_sizes, int n_in, void* d_out, int out_size, void* d_ws, size_t ws_size, hipStream_t stream) {
    static int grid = 0;
    if (grid == 0) {
        if (n_in != 17 || in_sizes[0] != M * DM || out_size != M * DM || ws_size < WS_END) { fprintf(stderr, "kernel_launch: unexpected shapes (n_in %d, in0 %d, out %d, ws %zu < %zu); nothing launched\n", n_in, n_in > 0 ? in_sizes[0] : -1, out_size, ws_size, (size_t)WS_END); grid = -1; return; }
        int dev = 0, cus = 0, per_cu = 0;
        if (hipGetDevice(&dev) != hipSuccess || hipDeviceGetAttribute(&cus, hipDeviceAttributeMultiprocessorCount, dev) != hipSuccess) { grid = -1; return; }
        if (hipFuncSetAttribute((const void*)fwd, hipFuncAttributeMaxDynamicSharedMemorySize, LDS_BYTES) != hipSuccess) { fprintf(stderr, "kernel_launch: hipFuncSetAttribute failed\n"); grid = -1; return; }
        if (hipOccupancyMaxActiveBlocksPerMultiprocessor(&per_cu, (const void*)fwd, NWAVES * 64, LDS_BYTES) != hipSuccess || per_cu < 1) fprintf(stderr, "kernel_launch: occupancy query reports %d\n", per_cu);
        (void)hipGetLastError();
        grid = cus;
    }
    if (grid < 0) return;
    if (hipMemsetAsync((char*)d_ws + WS_CTL, 0, CTL_ZERO_BYTES, stream) != hipSuccess) return;
    Args a{};
    for (int i = 0; i < 17; ++i) a.in[i] = d_in[i];
    a.out = (float*)d_out; a.ws = (unsigned char*)d_ws; a.li = 0; a.pad = 0;
#if MK_ONE_LAUNCH
    a.ph_lo = 0; a.ph_hi = N_PHASES;
    hipLaunchKernelGGL(fwd, dim3(grid), dim3(NWAVES * 64), LDS_BYTES, stream, a);
#else
    for (int p = 0; p < N_PHASES; ++p) { a.ph_lo = p; a.ph_hi = p + 1; hipLaunchKernelGGL(fwd, dim3(grid), dim3(NWAVES * 64), LDS_BYTES, stream, a); }
#endif
}
```
